# Optimizing an MI355X kernel written in HIP

```python
import math
import jax, jax.numpy as jnp
from jax import lax
import numpy as np

D_MODEL = 1024
BATCH = 4
SEQ = 4096
DEPTH = 1

PLE_DIM = 256
N_HEADS = 4
HEAD_DIM = 64
ATTN_W = N_HEADS * 2 * HEAD_DIM
N_POOL_GROUPS = 4
POOL_WINDOWS = (2, 4, 8, 16)
POOL_CH = 128
POOL_W = N_POOL_GROUPS * POOL_CH
MIX_W = ATTN_W + POOL_W
IN_W = 4 * ATTN_W + 2 * POOL_W
QBLK = 128
ALPHA = (2.0 * DEPTH) ** 0.25
BETA = (8.0 * DEPTH) ** -0.25
LN_EPS = 1e-5

kernel_name = "hybrid_diffattn_multipool_deepnorm"


def lambda_init(layer_idx):
    return 0.8 - 0.6 * math.exp(-0.3 * layer_idx)


def layer_norm(x, g, b):
    xf = x.astype(jnp.float32)
    mu = jnp.mean(xf, axis=-1, keepdims=True)
    var = jnp.mean(jnp.square(xf - mu), axis=-1, keepdims=True)
    y = (xf - mu) * lax.rsqrt(var + LN_EPS)
    return (y * g.astype(jnp.float32) + b.astype(jnp.float32)).astype(x.dtype)


def rms_norm(x, g):
    xf = x.astype(jnp.float32)
    y = xf * lax.rsqrt(jnp.mean(jnp.square(xf), axis=-1, keepdims=True) + LN_EPS)
    return (y * g.astype(jnp.float32)).astype(x.dtype)


def diff_attention(q, k, v, lam):
    B, S, H, _, Dh = q.shape
    nb = S // QBLK
    scale = 1.0 / math.sqrt(Dh)
    qb = q.reshape(B, nb, QBLK, H, 2, Dh).transpose(1, 0, 2, 3, 4, 5)
    kpos = jnp.arange(S)

    def block(args):
        qi, bi = args
        s = jnp.einsum('bqhcd,bkhcd->bhcqk', qi, k).astype(jnp.float32) * scale
        qpos = bi * QBLK + jnp.arange(QBLK)
        causal = kpos[None, :] <= qpos[:, None]
        s = jnp.where(causal, s, -jnp.inf)
        a = jax.nn.softmax(s, axis=-1)
        a = a[:, :, 0] - lam * a[:, :, 1]
        return jnp.einsum('bhqk,bkhe->bqhe', a.astype(v.dtype), v)

    o = lax.map(block, (qb, jnp.arange(nb)))
    return o.transpose(1, 0, 2, 3, 4).reshape(B, S, H, 2 * Dh)


def multiscale_pool(u, w_pool, scale):
    B, S, _ = u.shape
    ug = u.reshape(B, S, N_POOL_GROUPS, POOL_CH)
    c = jnp.cumsum(ug.astype(jnp.float32), axis=1)
    t = jnp.arange(1, S + 1, dtype=jnp.float32)
    means = []
    for g, w in enumerate(POOL_WINDOWS):
        cg = c[:, :, g]
        lag = jnp.pad(cg, ((0, 0), (w, 0), (0, 0)))[:, :S]
        cnt = jnp.minimum(t, float(w))[None, :, None]
        means.append((cg - lag) / cnt)
    mean = jnp.stack(means, axis=2).astype(u.dtype)
    d = mean - ug
    y = jnp.einsum('bsgc,gcd->bsgd', d, w_pool)
    return y.reshape(B, S, POOL_W) * scale


def setup_inputs(seed: int = 0) -> dict:
    key = jax.random.key(seed)
    ks = jax.random.split(key, 16)
    f32 = jnp.float32
    nrm = lambda k, shape, s: (jax.random.normal(k, shape, f32) * s)
    return {
        "x": nrm(ks[0], (BATCH, SEQ, D_MODEL), 1.0),
        "p": nrm(ks[1], (DEPTH, BATCH, SEQ, PLE_DIM), 1.0),
        "w_in": nrm(ks[2], (DEPTH, D_MODEL, IN_W), D_MODEL ** -0.5),
        "lam_q1": nrm(ks[3], (DEPTH, HEAD_DIM), 0.1),
        "lam_k1": nrm(ks[4], (DEPTH, HEAD_DIM), 0.1),
        "lam_q2": nrm(ks[5], (DEPTH, HEAD_DIM), 0.1),
        "lam_k2": nrm(ks[6], (DEPTH, HEAD_DIM), 0.1),
        "subln_g": 1.0 + nrm(ks[7], (DEPTH, 2 * HEAD_DIM), 0.05),
        "w_pool": nrm(ks[8], (DEPTH, N_POOL_GROUPS, POOL_CH, POOL_CH), POOL_CH ** -0.5),
        "pool_scale": 1.0 + nrm(ks[9], (DEPTH, POOL_W), 0.1),
        "w_out": nrm(ks[10], (DEPTH, MIX_W, D_MODEL), MIX_W ** -0.5 * BETA),
        "ln_g": 1.0 + nrm(ks[11], (DEPTH, D_MODEL), 0.05),
        "ln_b": nrm(ks[12], (DEPTH, D_MODEL), 0.02),
        "w_pe": nrm(ks[13], (DEPTH, PLE_DIM, D_MODEL), PLE_DIM ** -0.5),
        "w_pg": nrm(ks[14], (DEPTH, D_MODEL, D_MODEL), D_MODEL ** -0.5),
        "b_pg": nrm(ks[15], (DEPTH, D_MODEL), 0.02),
    }


def reference(x, p, w_in, lam_q1, lam_k1, lam_q2, lam_k2, subln_g, w_pool, pool_scale,
              w_out, ln_g, ln_b, w_pe, w_pg, b_pg):
    B, S, _ = x.shape
    h = x
    for i in range(DEPTH):
        lam_init = lambda_init(i)
        z = h @ w_in[i]
        q = z[..., 0:ATTN_W].reshape(B, S, N_HEADS, 2, HEAD_DIM)
        k = z[..., ATTN_W:2 * ATTN_W].reshape(B, S, N_HEADS, 2, HEAD_DIM)
        v = z[..., 2 * ATTN_W:3 * ATTN_W].reshape(B, S, N_HEADS, 2 * HEAD_DIM)
        g_attn = z[..., 3 * ATTN_W:4 * ATTN_W]
        u = z[..., 4 * ATTN_W:4 * ATTN_W + POOL_W]
        g_pool = z[..., 4 * ATTN_W + POOL_W:]

        lam = (jnp.exp(jnp.sum(lam_q1[i].astype(jnp.float32) * lam_k1[i].astype(jnp.float32)))
               - jnp.exp(jnp.sum(lam_q2[i].astype(jnp.float32) * lam_k2[i].astype(jnp.float32)))
               + lam_init)
        o = diff_attention(q, k, v, lam)
        o = rms_norm(o, subln_g[i]) * (1.0 - lam_init)
        attn_out = o.reshape(B, S, ATTN_W) * jax.nn.silu(g_attn)

        pool_out = multiscale_pool(u, w_pool[i], pool_scale[i]) * jax.nn.silu(g_pool)

        mix = jnp.concatenate([attn_out, pool_out], axis=-1) @ w_out[i]
        h = layer_norm(ALPHA * h + mix, ln_g[i], ln_b[i])

        gate = jax.nn.sigmoid(h @ w_pg[i] + b_pg[i])
        h = h + (p[i] @ w_pe[i]) * gate
    return h
```

```cpp
#include <hip/hip_runtime.h>
#include <cstdio>
#include <cstdint>

typedef unsigned short bf16_t;
typedef float f32x4 __attribute__((ext_vector_type(4)));
typedef unsigned u32x4 __attribute__((ext_vector_type(4)));
typedef unsigned u32x2 __attribute__((ext_vector_type(2)));

constexpr int Bn = 4, S = 4096, DM = 1024, M = Bn * S, PLE = 256, INW = 3072, AW = 512;
constexpr float LN_EPS = 1e-5f;
constexpr float LAM_INIT = 0.2f;
constexpr float ALPHA = 1.189207115002721f;
constexpr float QSCALE = 0.125f * 1.4426950408889634f;

struct P {
    const float *x, *p, *w_in, *lq1, *lk1, *lq2, *lk2, *subln_g, *w_pool, *pool_scale, *w_out, *ln_g, *ln_b, *w_pe, *w_pg, *b_pg;
    float* out;
    bf16_t *xb, *pb, *wi_t, *wo_t, *wg_t, *we_t, *wp_t;
    bf16_t *qb, *kb, *vT, *sga, *ub, *sgp, *pe, *mixin, *hb, *dpool;
};

__device__ __forceinline__ float bf2f(bf16_t v) { return __uint_as_float(((unsigned)v) << 16); }
__device__ __forceinline__ bf16_t f2bf(float x) { unsigned u = __float_as_uint(x); u += 0x7fffu + ((u >> 16) & 1u); return (bf16_t)(u >> 16); }
__device__ __forceinline__ unsigned pk2(float lo, float hi) { return (unsigned)f2bf(lo) | ((unsigned)f2bf(hi) << 16); }
__device__ __forceinline__ float silu(float v) { return v / (1.f + __expf(-v)); }
__device__ __forceinline__ float sigmoidf(float v) { return 1.f / (1.f + __expf(-v)); }

__device__ __forceinline__ float compute_lam(const P& p) {
    float a = 0.f, b = 0.f;
    for (int i = 0; i < 64; ++i) { a += p.lq1[i] * p.lk1[i]; b += p.lq2[i] * p.lk2[i]; }
    return expf(a) - expf(b) + LAM_INIT;
}

__global__ void __launch_bounds__(256) k_cvt(const float* __restrict__ src, bf16_t* __restrict__ dst, long n8) {
    for (long i = (long)blockIdx.x * blockDim.x + threadIdx.x; i < n8; i += (long)gridDim.x * blockDim.x) {
        f32x4 a = *(const f32x4*)(src + i * 8), b = *(const f32x4*)(src + i * 8 + 4);
        u32x4 w; w.x = pk2(a.x, a.y); w.y = pk2(a.z, a.w); w.z = pk2(b.x, b.y); w.w = pk2(b.z, b.w);
        *(u32x4*)(dst + i * 8) = w;
    }
}
__global__ void __launch_bounds__(256) k_transpose(const float* __restrict__ w, bf16_t* __restrict__ wt, int K, int N) {
    __shared__ float tile[64][65];
    const int nkt = K / 64, nnt = N / 64, t = threadIdx.x;
    for (int u = blockIdx.x; u < nkt * nnt; u += gridDim.x) {
        const int kt = u / nnt, nt = u % nnt;
        __syncthreads();
        for (int i = 0; i < 16; ++i) { int idx = t + 256 * i, k = idx >> 6, n = idx & 63; tile[k][n] = w[(long)(kt * 64 + k) * N + nt * 64 + n]; }
        __syncthreads();
        for (int i = 0; i < 16; ++i) { int idx = t + 256 * i, n = idx >> 6, k = idx & 63; wt[(long)(nt * 64 + n) * K + kt * 64 + k] = f2bf(tile[k][n]); }
    }
}

enum { G_IN = 0, G_PE = 1, G_OUT = 2, G_GATE = 3 };
template <int G> __device__ __forceinline__ void epi4(const P& p, int row, int col, float v0, float v1, float v2, float v3) {
    if (G == G_IN) {
        const int reg = col >> 9, cc = col & 511;
        if (reg == 2) {
            const int b = row / S, s = row % S, h = cc >> 7, e = cc & 127;
            bf16_t* d = p.vT + ((long)(b * 4 + h) * 128 + e) * S + s;
            d[0] = f2bf(v0); d[S] = f2bf(v1); d[2 * S] = f2bf(v2); d[3 * S] = f2bf(v3);
        } else {
            bf16_t* d;
            if (reg == 0) { d = p.qb; v0 *= QSCALE; v1 *= QSCALE; v2 *= QSCALE; v3 *= QSCALE; }
            else if (reg == 1) d = p.kb;
            else if (reg == 3) { d = p.sga; v0 = silu(v0); v1 = silu(v1); v2 = silu(v2); v3 = silu(v3); }
            else if (reg == 4) d = p.ub;
            else { d = p.sgp; v0 = silu(v0); v1 = silu(v1); v2 = silu(v2); v3 = silu(v3); }
            u32x2 w; w.x = pk2(v0, v1); w.y = pk2(v2, v3);
            *(u32x2*)(d + (long)row * AW + cc) = w;
        }
    } else if (G == G_PE) {
        u32x2 w; w.x = pk2(v0, v1); w.y = pk2(v2, v3);
        *(u32x2*)(p.pe + (long)row * DM + col) = w;
    } else if (G == G_OUT) {
        const f32x4 xv = *(const f32x4*)(p.x + (long)row * DM + col);
        f32x4 r; r.x = ALPHA * xv.x + v0; r.y = ALPHA * xv.y + v1; r.z = ALPHA * xv.z + v2; r.w = ALPHA * xv.w + v3;
        *(f32x4*)(p.out + (long)row * DM + col) = r;
    } else {
        const f32x4 hv = *(const f32x4*)(p.out + (long)row * DM + col);
        const f32x4 bv = *(const f32x4*)(p.b_pg + col);
        const u32x2 pw = *(const u32x2*)(p.pe + (long)row * DM + col);
        const float e0 = __uint_as_float(pw.x << 16), e1 = __uint_as_float(pw.x & 0xffff0000u), e2 = __uint_as_float(pw.y << 16), e3 = __uint_as_float(pw.y & 0xffff0000u);
        f32x4 r; r.x = hv.x + e0 * sigmoidf(v0 + bv.x); r.y = hv.y + e1 * sigmoidf(v1 + bv.y); r.z = hv.z + e2 * sigmoidf(v2 + bv.z); r.w = hv.w + e3 * sigmoidf(v3 + bv.w);
        *(f32x4*)(p.out + (long)row * DM + col) = r;
    }
}

template <int G> __global__ void __launch_bounds__(512) k_gemm_naive(P p, const bf16_t* __restrict__ A, const bf16_t* __restrict__ Bt, int N, int K) {
    __shared__ float As[128][33];
    __shared__ float Bs[64][33];
    const int t = threadIdx.x, ty = t >> 4, tx = t & 15;
    const int ntn = N / 64, ntm = M / 128;
    for (int u = blockIdx.x; u < ntn * ntm; u += gridDim.x) {
        const int tm = u / ntn, tn = u % ntn;
        float acc[4][4];
        for (int i = 0; i < 4; ++i) for (int j = 0; j < 4; ++j) acc[i][j] = 0.f;
        for (int k0 = 0; k0 < K; k0 += 32) {
            __syncthreads();
            for (int i = 0; i < 8; ++i) { int idx = t + 512 * i, r = idx >> 5, c = idx & 31; As[r][c] = bf2f(A[(long)(tm * 128 + r) * K + k0 + c]); }
            for (int i = 0; i < 4; ++i) { int idx = t + 512 * i, r = idx >> 5, c = idx & 31; Bs[r][c] = bf2f(Bt[(long)(tn * 64 + r) * K + k0 + c]); }
            __syncthreads();
            for (int kk = 0; kk < 32; ++kk) {
                float a[4], b[4];
                for (int i = 0; i < 4; ++i) a[i] = As[ty * 4 + i][kk];
                for (int j = 0; j < 4; ++j) b[j] = Bs[tx * 4 + j][kk];
                for (int i = 0; i < 4; ++i) for (int j = 0; j < 4; ++j) acc[i][j] += a[i] * b[j];
            }
        }
        for (int i = 0; i < 4; ++i) epi4<G>(p, tm * 128 + ty * 4 + i, tn * 64 + tx * 4, acc[i][0], acc[i][1], acc[i][2], acc[i][3]);
    }
}

__global__ void __launch_bounds__(64) k_attn_naive(P p, float* __restrict__ otmp) {
    const int item = blockIdx.x * 64 + threadIdx.x;
    const int s = item % S, c = (item / S) & 1, h = (item / (2 * S)) & 3, b = item / (8 * S);
    float q[64];
    {
        const bf16_t* qp = p.qb + (long)(b * S + s) * AW + h * 128 + c * 64;
#pragma unroll
        for (int d = 0; d < 64; ++d) q[d] = bf2f(qp[d]);
    }
    float acc[128];
#pragma unroll
    for (int e = 0; e < 128; ++e) acc[e] = 0.f;
    float m = -1e30f, l = 0.f;
    const int smax = __shfl(s, 63);
    const bf16_t* kbase = p.kb + (long)(b * S) * AW + h * 128 + c * 64;
    const bf16_t* vbase = p.vT + (long)(b * 4 + h) * 128 * S;
    for (int j0 = 0; j0 <= smax; j0 += 8) {
        float sc[8];
        float mx = m;
#pragma unroll
        for (int jj = 0; jj < 8; ++jj) {
            const bf16_t* kp = kbase + (long)(j0 + jj) * AW;
            float dot = 0.f;
#pragma unroll
            for (int d8 = 0; d8 < 8; ++d8) {
                const u32x4 kw = *(const u32x4*)(kp + d8 * 8);
                dot += q[d8 * 8 + 0] * __uint_as_float(kw.x << 16) + q[d8 * 8 + 1] * __uint_as_float(kw.x & 0xffff0000u)
                     + q[d8 * 8 + 2] * __uint_as_float(kw.y << 16) + q[d8 * 8 + 3] * __uint_as_float(kw.y & 0xffff0000u)
                     + q[d8 * 8 + 4] * __uint_as_float(kw.z << 16) + q[d8 * 8 + 5] * __uint_as_float(kw.z & 0xffff0000u)
                     + q[d8 * 8 + 6] * __uint_as_float(kw.w << 16) + q[d8 * 8 + 7] * __uint_as_float(kw.w & 0xffff0000u);
            }
            sc[jj] = (j0 + jj <= s) ? dot : -1e30f;
            mx = fmaxf(mx, sc[jj]);
        }
        const float alpha = exp2f(m - mx);
        m = mx;
        float ps = 0.f;
#pragma unroll
        for (int jj = 0; jj < 8; ++jj) { sc[jj] = (j0 + jj <= s) ? exp2f(sc[jj] - mx) : 0.f; ps += sc[jj]; }
        l = l * alpha + ps;
#pragma unroll
        for (int e = 0; e < 128; ++e) {
            const u32x4 vw = *(const u32x4*)(vbase + (long)e * S + j0);
            float a = acc[e] * alpha;
            a += sc[0] * __uint_as_float(vw.x << 16) + sc[1] * __uint_as_float(vw.x & 0xffff0000u)
               + sc[2] * __uint_as_float(vw.y << 16) + sc[3] * __uint_as_float(vw.y & 0xffff0000u)
               + sc[4] * __uint_as_float(vw.z << 16) + sc[5] * __uint_as_float(vw.z & 0xffff0000u)
               + sc[6] * __uint_as_float(vw.w << 16) + sc[7] * __uint_as_float(vw.w & 0xffff0000u);
            acc[e] = a;
        }
    }
    const float inv = 1.f / l;
    float* op = otmp + (long)(b * S + s) * 1024 + h * 256 + c * 128;
#pragma unroll
    for (int e = 0; e < 128; ++e) op[e] = acc[e] * inv;
}

__global__ void __launch_bounds__(256) k_combine(P p, const float* __restrict__ otmp) {
    const float lam = compute_lam(p);
    const int lane = threadIdx.x & 63;
    const int item = blockIdx.x * 4 + (threadIdx.x >> 6);
    const int tok = item >> 2, h = item & 3;
    const float* o1 = otmp + (long)tok * 1024 + h * 256;
    float a0 = o1[lane] - lam * o1[128 + lane], a1 = o1[64 + lane] - lam * o1[192 + lane];
    float ss = a0 * a0 + a1 * a1;
    for (int off = 32; off > 0; off >>= 1) ss += __shfl_xor(ss, off);
    const float r = rsqrtf(ss * (1.f / 128.f) + LN_EPS) * (1.f - LAM_INIT);
    const long base = (long)tok * AW + h * 128;
    p.mixin[(long)tok * DM + h * 128 + lane] = f2bf(a0 * r * p.subln_g[lane] * bf2f(p.sga[base + lane]));
    p.mixin[(long)tok * DM + h * 128 + 64 + lane] = f2bf(a1 * r * p.subln_g[64 + lane] * bf2f(p.sga[base + 64 + lane]));
}

__global__ void __launch_bounds__(256) k_pool_d(P p) {
    const long idx = (long)blockIdx.x * 256 + threadIdx.x;
    const int ch = (int)(idx & 511); const int tok = (int)(idx >> 9); const int s = tok % S;
    const int g = ch >> 7, w = 2 << g;
    const int cnt = min(s + 1, w);
    float sum = 0.f;
    for (int j = 0; j < cnt; ++j) sum += bf2f(p.ub[(long)(tok - j) * AW + ch]);
    const float d = sum / (float)cnt - bf2f(p.ub[(long)tok * AW + ch]);
    p.dpool[idx] = f2bf(d);
}
__global__ void __launch_bounds__(256) k_pool_mm(P p) {
    const long idx = (long)blockIdx.x * 256 + threadIdx.x;
    const int col = (int)(idx & 511); const long tok = idx >> 9; const int g = col >> 7, dc = col & 127;
    const bf16_t* dp = p.dpool + tok * AW + g * 128;
    const bf16_t* wp = p.wp_t + (long)(g * 128 + dc) * 128;
    float acc = 0.f;
    for (int c = 0; c < 128; ++c) acc += bf2f(dp[c]) * bf2f(wp[c]);
    p.mixin[tok * DM + 512 + col] = f2bf(acc * p.pool_scale[col] * bf2f(p.sgp[tok * AW + col]));
}

__global__ void __launch_bounds__(256) k_ln(P p) {
    const int lane = threadIdx.x & 63;
    const int row = blockIdx.x * 4 + (threadIdx.x >> 6);
    float* rp = p.out + (long)row * DM;
    f32x4 v[4];
    float sum = 0.f;
    for (int i = 0; i < 4; ++i) { v[i] = *(const f32x4*)(rp + i * 256 + lane * 4); sum += v[i].x + v[i].y + v[i].z + v[i].w; }
    for (int off = 32; off > 0; off >>= 1) sum += __shfl_xor(sum, off);
    const float mu = sum * (1.f / 1024.f);
    float sq = 0.f;
    for (int i = 0; i < 4; ++i) { v[i].x -= mu; v[i].y -= mu; v[i].z -= mu; v[i].w -= mu; sq += v[i].x * v[i].x + v[i].y * v[i].y + v[i].z * v[i].z + v[i].w * v[i].w; }
    for (int off = 32; off > 0; off >>= 1) sq += __shfl_xor(sq, off);
    const float rstd = rsqrtf(sq * (1.f / 1024.f) + LN_EPS);
    for (int i = 0; i < 4; ++i) {
        const int c = i * 256 + lane * 4;
        const f32x4 g = *(const f32x4*)(p.ln_g + c), bb = *(const f32x4*)(p.ln_b + c);
        f32x4 h; h.x = v[i].x * rstd * g.x + bb.x; h.y = v[i].y * rstd * g.y + bb.y; h.z = v[i].z * rstd * g.z + bb.z; h.w = v[i].w * rstd * g.w + bb.w;
        *(f32x4*)(rp + c) = h;
        u32x2 w; w.x = pk2(h.x, h.y); w.y = pk2(h.z, h.w);
        *(u32x2*)(p.hb + (long)row * DM + c) = w;
    }
}

extern "C" void kernel_launch(void* const* d_in, const int* in_sizes, int n_in, void* d_out, int out_size, void* d_ws, size_t ws_size, hipStream_t stream) {
    P p{};
    p.x = (const float*)d_in[0]; p.p = (const float*)d_in[1]; p.w_in = (const float*)d_in[2];
    p.lq1 = (const float*)d_in[3]; p.lk1 = (const float*)d_in[4]; p.lq2 = (const float*)d_in[5]; p.lk2 = (const float*)d_in[6];
    p.subln_g = (const float*)d_in[7]; p.w_pool = (const float*)d_in[8]; p.pool_scale = (const float*)d_in[9];
    p.w_out = (const float*)d_in[10]; p.ln_g = (const float*)d_in[11]; p.ln_b = (const float*)d_in[12];
    p.w_pe = (const float*)d_in[13]; p.w_pg = (const float*)d_in[14]; p.b_pg = (const float*)d_in[15];
    p.out = (float*)d_out;
    char* w = (char*)d_ws; size_t off = 0;
    auto take = [&](size_t bytes) { char* r = w + off; off += (bytes + 255) & ~(size_t)255; return (bf16_t*)r; };
    p.xb = take((size_t)M * DM * 2); p.pb = take((size_t)M * PLE * 2);
    p.wi_t = take((size_t)INW * DM * 2); p.wo_t = take((size_t)DM * DM * 2); p.wg_t = take((size_t)DM * DM * 2);
    p.we_t = take((size_t)DM * PLE * 2); p.wp_t = take((size_t)4 * 128 * 128 * 2);
    p.qb = take((size_t)M * AW * 2); p.kb = take((size_t)M * AW * 2); p.vT = take((size_t)M * AW * 2);
    p.sga = take((size_t)M * AW * 2); p.ub = take((size_t)M * AW * 2); p.sgp = take((size_t)M * AW * 2);
    p.pe = take((size_t)M * DM * 2); p.mixin = take((size_t)M * DM * 2); p.dpool = take((size_t)M * AW * 2);
    p.hb = p.xb;
    if (off > ws_size) { fprintf(stderr, "workspace too small: need %zu have %zu\n", off, ws_size); return; }

    k_cvt<<<2048, 256, 0, stream>>>(p.x, p.xb, (long)M * DM / 8);
    k_cvt<<<1024, 256, 0, stream>>>(p.p, p.pb, (long)M * PLE / 8);
    k_transpose<<<768, 256, 0, stream>>>(p.w_in, p.wi_t, DM, INW);
    k_transpose<<<256, 256, 0, stream>>>(p.w_out, p.wo_t, DM, DM);
    k_transpose<<<256, 256, 0, stream>>>(p.w_pg, p.wg_t, DM, DM);
    k_transpose<<<64, 256, 0, stream>>>(p.w_pe, p.we_t, PLE, DM);
    for (int g = 0; g < 4; ++g) k_transpose<<<4, 256, 0, stream>>>(p.w_pool + g * 128 * 128, p.wp_t + g * 128 * 128, 128, 128);
    k_gemm_naive<G_IN><<<2048, 512, 0, stream>>>(p, p.xb, p.wi_t, INW, DM);
    k_gemm_naive<G_PE><<<2048, 512, 0, stream>>>(p, p.pb, p.we_t, DM, PLE);
    k_attn_naive<<<M * 8 / 64, 64, 0, stream>>>(p, p.out);
    k_combine<<<M, 256, 0, stream>>>(p, p.out);
    k_pool_d<<<M * 512 / 256, 256, 0, stream>>>(p);
    k_pool_mm<<<M * 512 / 256, 256, 0, stream>>>(p);
    k_gemm_naive<G_OUT><<<2048, 512, 0, stream>>>(p, p.mixin, p.wo_t, DM, DM);
    k_ln<<<M / 4, 256, 0, stream>>>(p);
    k_gemm_naive<G_GATE><<<2048, 512, 0, stream>>>(p, p.hb, p.wg_t, DM, DM);
}
```

```cpp
#include <hip/hip_runtime.h>
#include <hip/hip_cooperative_groups.h>
#include <cstdio>
#include <cstdint>
namespace cg = cooperative_groups;

#ifndef MK_ONE
#define MK_ONE 1
#endif

typedef unsigned short bf16_t;
typedef float f32x4 __attribute__((ext_vector_type(4)));
typedef float f32x16 __attribute__((ext_vector_type(16)));
typedef unsigned u32x4 __attribute__((ext_vector_type(4)));
typedef unsigned u32x2 __attribute__((ext_vector_type(2)));
typedef short bf16x8 __attribute__((ext_vector_type(8)));

constexpr int Bn = 4, S = 4096, DM = 1024, M = Bn * S, PLE = 256, INW = 3072, AW = 512;
constexpr float LN_EPS = 1e-5f;
constexpr float LAM_INIT = 0.2f;
constexpr float ALPHA = 1.189207115002721f;
constexpr float QSCALE = 0.125f * 1.4426950408889634f;
constexpr int NT = 512;
constexpr int LDS_BYTES = 131072;

struct P {
    const float *x, *p, *w_in, *lq1, *lk1, *lq2, *lk2, *subln_g, *w_pool, *pool_scale, *w_out, *ln_g, *ln_b, *w_pe, *w_pg, *b_pg;
    float* out;
    bf16_t *xb, *pb, *wi_t, *wo_t, *wg_t, *we_t, *wp_t;
    bf16_t *qb, *kb, *vT, *sga, *ub, *sgp, *pe, *mixin, *hb;
};

#define MFMA32(a, b, c) __builtin_amdgcn_mfma_f32_32x32x16_bf16((a), (b), (c), 0, 0, 0)
__device__ __forceinline__ int crow(int r, int hi) { return (r & 3) + 8 * (r >> 2) + 4 * hi; }
__device__ __forceinline__ float bf2f(bf16_t v) { return __uint_as_float(((unsigned)v) << 16); }
__device__ __forceinline__ float bflo(unsigned w) { return __uint_as_float(w << 16); }
__device__ __forceinline__ float bfhi(unsigned w) { return __uint_as_float(w & 0xffff0000u); }
typedef __bf16 bf16x2_t __attribute__((ext_vector_type(2)));
typedef float f32x2 __attribute__((ext_vector_type(2)));
__device__ __forceinline__ unsigned pk2(float lo, float hi) { const f32x2 f = {lo, hi}; return __builtin_bit_cast(unsigned, __builtin_convertvector(f, bf16x2_t)); }
__device__ __forceinline__ float silu(float v) { return v / (1.f + __expf(-v)); }
__device__ __forceinline__ float sigmoidf(float v) { return 1.f / (1.f + __expf(-v)); }
__device__ __forceinline__ int lds_off(int row, int chunk) { return row * 128 + ((chunk ^ ((row >> 1) & 7)) << 4); }

__device__ __forceinline__ float compute_lam(const P& p) {
    float a = 0.f, b = 0.f;
    for (int i = 0; i < 64; ++i) { a += p.lq1[i] * p.lk1[i]; b += p.lq2[i] * p.lk2[i]; }
    return expf(a) - expf(b) + LAM_INIT;
}

__device__ __forceinline__ void cvt_range(const float* __restrict__ src, bf16_t* __restrict__ dst, long n8) {
    for (long i = (long)blockIdx.x * NT + threadIdx.x; i < n8; i += (long)gridDim.x * NT) {
        const f32x4 a = *(const f32x4*)(src + i * 8), b = *(const f32x4*)(src + i * 8 + 4);
        u32x4 w; w.x = pk2(a.x, a.y); w.y = pk2(a.z, a.w); w.z = pk2(b.x, b.y); w.w = pk2(b.z, b.w);
        *(u32x4*)(dst + i * 8) = w;
    }
}
__device__ __forceinline__ void transpose_tile(const float* __restrict__ w, bf16_t* __restrict__ wt, int K, int N, int kt, int nt, float* tile  ) {
    const int t = threadIdx.x;
    __syncthreads();
#pragma unroll
    for (int i = 0; i < 8; ++i) { const int idx = t + NT * i, k = idx >> 6, n = idx & 63; tile[k * 65 + n] = w[(long)(kt * 64 + k) * N + nt * 64 + n]; }
    __syncthreads();
    {
        const int n = t >> 3, kc = t & 7;
        float v[8];
#pragma unroll
        for (int j = 0; j < 8; ++j) v[j] = tile[(kc * 8 + j) * 65 + n];
        u32x4 o; o.x = pk2(v[0], v[1]); o.y = pk2(v[2], v[3]); o.z = pk2(v[4], v[5]); o.w = pk2(v[6], v[7]);
        *(u32x4*)(wt + (long)(nt * 64 + n) * K + kt * 64 + kc * 8) = o;
    }
}
__device__ __forceinline__ void phase0(const P& p, char* lds) {
    float* tile = (float*)lds;
    for (int u = blockIdx.x; u < 1360; u += gridDim.x) {
        if (u < 768) transpose_tile(p.w_in, p.wi_t, DM, INW, u / 48, u % 48, tile);
        else if (u < 1024) { const int v = u - 768; transpose_tile(p.w_out, p.wo_t, DM, DM, v >> 4, v & 15, tile); }
        else if (u < 1280) { const int v = u - 1024; transpose_tile(p.w_pg, p.wg_t, DM, DM, v >> 4, v & 15, tile); }
        else if (u < 1344) { const int v = u - 1280; transpose_tile(p.w_pe, p.we_t, PLE, DM, v >> 4, v & 15, tile); }
        else { const int v = u - 1344, g = v >> 2; transpose_tile(p.w_pool + g * 16384, p.wp_t + g * 16384, 128, 128, (v >> 1) & 1, v & 1, tile); }
    }
    cvt_range(p.x, p.xb, (long)M * DM / 8);
    cvt_range(p.p, p.pb, (long)M * PLE / 8);
}

enum { G_IN = 0, G_PE = 1, G_OUT = 2, G_GATE = 3 };
template <int G> __device__ __forceinline__ void epi4(const P& p, int row, int col, float v0, float v1, float v2, float v3) {
    if (G == G_IN) {
        const int reg = col >> 9, cc = col & 511;
        bf16_t* d;
        if (reg == 0) { d = p.qb; v0 *= QSCALE; v1 *= QSCALE; v2 *= QSCALE; v3 *= QSCALE; }
        else if (reg == 1) d = p.kb;
        else if (reg == 3) { d = p.sga; v0 = silu(v0); v1 = silu(v1); v2 = silu(v2); v3 = silu(v3); }
        else if (reg == 4) d = p.ub;
        else { d = p.sgp; v0 = silu(v0); v1 = silu(v1); v2 = silu(v2); v3 = silu(v3); }
        u32x2 w; w.x = pk2(v0, v1); w.y = pk2(v2, v3);
        *(u32x2*)(d + (long)row * AW + cc) = w;
    } else if (G == G_PE) {
        u32x2 w; w.x = pk2(v0, v1); w.y = pk2(v2, v3);
        *(u32x2*)(p.pe + (long)row * DM + col) = w;
    } else if (G == G_OUT) {
        const f32x4 xv = *(const f32x4*)(p.x + (long)row * DM + col);
        f32x4 r; r.x = ALPHA * xv.x + v0; r.y = ALPHA * xv.y + v1; r.z = ALPHA * xv.z + v2; r.w = ALPHA * xv.w + v3;
        *(f32x4*)(p.out + (long)row * DM + col) = r;
    } else {
        const f32x4 hv = *(const f32x4*)(p.out + (long)row * DM + col);
        const f32x4 bv = *(const f32x4*)(p.b_pg + col);
        const u32x2 pw = *(const u32x2*)(p.pe + (long)row * DM + col);
        f32x4 r; r.x = hv.x + bflo(pw.x) * sigmoidf(v0 + bv.x); r.y = hv.y + bfhi(pw.x) * sigmoidf(v1 + bv.y);
        r.z = hv.z + bflo(pw.y) * sigmoidf(v2 + bv.z); r.w = hv.w + bfhi(pw.y) * sigmoidf(v3 + bv.w);
        *(f32x4*)(p.out + (long)row * DM + col) = r;
    }
}
__device__ __forceinline__ void epiV(const P& p, int row0, int col, float v0, float v1, float v2, float v3) {
    const int cc = col - 1024, h = cc >> 7, e = cc & 127, b = row0 / S, s = row0 % S;
    const int piece = (s >> 2) & 3, np = ((piece & 1) << 1) | (piece >> 1);
    const int pos = (s & ~15) | (np << 2);
    u32x2 w; w.x = pk2(v0, v1); w.y = pk2(v2, v3);
    *(u32x2*)(p.vT + ((long)(b * 4 + h) * 128 + e) * S + pos) = w;
}

template <int G, bool SWAP>
__device__ __forceinline__ void gemm_tile(const P& p, const bf16_t* __restrict__ A, const bf16_t* __restrict__ Bt, const int K, const int row0, const int col0, char* lds) {
    const int t = threadIdx.x, wid = t >> 6, lane = t & 63, wm = wid >> 2, wn = wid & 3, l31 = lane & 31, hi = lane >> 5;
    f32x16 acc[4][2];
#pragma unroll
    for (int i = 0; i < 4; ++i)
#pragma unroll
        for (int j = 0; j < 2; ++j)
#pragma unroll
            for (int r = 0; r < 16; ++r) acc[i][j][r] = 0.f;
    const bf16_t* ag = A + (long)(row0 + (t >> 3)) * K + (t & 7) * 8;
    const bf16_t* bg = Bt + (long)(col0 + (t >> 3)) * K + (t & 7) * 8;
    const long gstep = (long)64 * K;
    const int soff = lds_off(t >> 3, t & 7);
    const int sw = (l31 >> 1) & 7;
    int coff[4];
#pragma unroll
    for (int kk = 0; kk < 4; ++kk) coff[kk] = ((kk * 2 + hi) ^ sw) << 4;
    const int arow = (wm * 128 + l31) * 128, brow = 32768 + (wn * 64 + l31) * 128;
    const int nk = K >> 6;
    u32x4 ra[4], rb[4];
#pragma unroll
    for (int i = 0; i < 4; ++i) { ra[i] = *(const u32x4*)(ag + i * gstep); rb[i] = *(const u32x4*)(bg + i * gstep); }
    __syncthreads();
#pragma unroll
    for (int i = 0; i < 4; ++i) { *(u32x4*)(lds + soff + i * 8192) = ra[i]; *(u32x4*)(lds + 32768 + soff + i * 8192) = rb[i]; }
    __syncthreads();
    for (int kt = 0; kt < nk; ++kt) {
        const char* cur = lds + (kt & 1) * 65536;
        char* nxt = lds + ((kt + 1) & 1) * 65536;
        const bool more = kt + 1 < nk;
        if (more) {
#pragma unroll
            for (int i = 0; i < 4; ++i) { ra[i] = *(const u32x4*)(ag + (kt + 1) * 64 + i * gstep); rb[i] = *(const u32x4*)(bg + (kt + 1) * 64 + i * gstep); }
        }
#pragma unroll
        for (int kk = 0; kk < 4; ++kk) {
            bf16x8 af[4], bfr[2];
#pragma unroll
            for (int i = 0; i < 4; ++i) af[i] = *(const bf16x8*)(cur + arow + i * 4096 + coff[kk]);
#pragma unroll
            for (int j = 0; j < 2; ++j) bfr[j] = *(const bf16x8*)(cur + brow + j * 4096 + coff[kk]);
#pragma unroll
            for (int i = 0; i < 4; ++i)
#pragma unroll
                for (int j = 0; j < 2; ++j) acc[i][j] = SWAP ? MFMA32(af[i], bfr[j], acc[i][j]) : MFMA32(bfr[j], af[i], acc[i][j]);
        }
        if (more) {
#pragma unroll
            for (int i = 0; i < 4; ++i) { *(u32x4*)(nxt + soff + i * 8192) = ra[i]; *(u32x4*)(nxt + 32768 + soff + i * 8192) = rb[i]; }
        }
        __syncthreads();
    }
#pragma unroll
    for (int i = 0; i < 4; ++i)
#pragma unroll
        for (int j = 0; j < 2; ++j)
#pragma unroll
            for (int g = 0; g < 4; ++g) {
                if (SWAP) epiV(p, row0 + wm * 128 + i * 32 + 8 * g + 4 * hi, col0 + wn * 64 + j * 32 + l31, acc[i][j][4 * g], acc[i][j][4 * g + 1], acc[i][j][4 * g + 2], acc[i][j][4 * g + 3]);
                else epi4<G>(p, row0 + wm * 128 + i * 32 + l31, col0 + wn * 64 + j * 32 + 8 * g + 4 * hi, acc[i][j][4 * g], acc[i][j][4 * g + 1], acc[i][j][4 * g + 2], acc[i][j][4 * g + 3]);
            }
}

__device__ __forceinline__ void unit_map(int u, int& tm, int& tn) { const int xcd = u & 7, local = u >> 3; tm = xcd * 8 + (local & 7); tn = local >> 3; }

__device__ __forceinline__ void phase1(const P& p, char* lds) {
    for (int u = blockIdx.x; u < 64 * 16; u += gridDim.x) {
        int tm, tn; unit_map(u, tm, tn);
        if (tn < 12) {
            if ((tn >> 1) == 2) gemm_tile<G_IN, true>(p, p.xb, p.wi_t, DM, tm * 256, tn * 256, lds);
            else gemm_tile<G_IN, false>(p, p.xb, p.wi_t, DM, tm * 256, tn * 256, lds);
        } else gemm_tile<G_PE, false>(p, p.pb, p.we_t, PLE, tm * 256, (tn - 12) * 256, lds);
    }
}
__device__ __forceinline__ void phase3(const P& p, char* lds) {
    for (int u = blockIdx.x; u < 64 * 4; u += gridDim.x) { int tm, tn; unit_map(u, tm, tn); gemm_tile<G_OUT, false>(p, p.mixin, p.wo_t, DM, tm * 256, tn * 256, lds); }
}
__device__ __forceinline__ void phase5(const P& p, char* lds) {
    for (int u = blockIdx.x; u < 64 * 4; u += gridDim.x) { int tm, tn; unit_map(u, tm, tn); gemm_tile<G_GATE, false>(p, p.hb, p.wg_t, DM, tm * 256, tn * 256, lds); }
}

__device__ __forceinline__ void attn_item(const P& p, const int b, const int h, const int qt, const float lam, char* lds) {
    const int t = threadIdx.x, wid = t >> 6, lane = t & 63, c = wid >> 2, wq = wid & 3, l31 = lane & 31, hi = lane >> 5;
    const int q0w = qt * 128 + wq * 32;
    const long tok = (long)b * S + q0w + l31;
    bf16x8 qf[4];
#pragma unroll
    for (int kk = 0; kk < 4; ++kk) qf[kk] = *(const bf16x8*)(p.qb + tok * AW + h * 128 + c * 64 + (kk * 2 + hi) * 8);
    f32x16 oacc[4];
#pragma unroll
    for (int eb = 0; eb < 4; ++eb)
#pragma unroll
        for (int r = 0; r < 16; ++r) oacc[eb][r] = 0.f;
    float m = -1e30f, l = 0.f;
    const int ntile = 2 * qt + 2;
    const bf16_t* kg[2]; const bf16_t* vg[2]; int ko[2], vo[2];
#pragma unroll
    for (int i = 0; i < 2; ++i) {
        const int id = t + NT * i, key = id >> 4, c16 = id & 15;
        kg[i] = p.kb + ((long)b * S + key) * AW + h * 128 + c16 * 8;
        ko[i] = (c16 >> 3) * 8192 + lds_off(key, c16 & 7);
        const int e = id >> 3, ch = id & 7;
        vg[i] = p.vT + ((long)(b * 4 + h) * 128 + e) * S + ch * 8;
        vo[i] = 16384 + lds_off(e, ch);
    }
    const int sw = (l31 >> 1) & 7;
    int coff[4];
#pragma unroll
    for (int kk = 0; kk < 4; ++kk) coff[kk] = ((kk * 2 + hi) ^ sw) << 4;
    const int krow = c * 8192 + l31 * 128, vrow = 16384 + l31 * 128;
    u32x4 rk[2], rv[2];
#pragma unroll
    for (int i = 0; i < 2; ++i) { rk[i] = *(const u32x4*)(kg[i]); rv[i] = *(const u32x4*)(vg[i]); }
    __syncthreads();
#pragma unroll
    for (int i = 0; i < 2; ++i) { *(u32x4*)(lds + ko[i]) = rk[i]; *(u32x4*)(lds + vo[i]) = rv[i]; }
    __syncthreads();
    for (int jt = 0; jt < ntile; ++jt) {
        const char* cur = lds + (jt & 1) * 32768;
        char* nxt = lds + ((jt + 1) & 1) * 32768;
        const bool more = jt + 1 < ntile;
        if (more) {
#pragma unroll
            for (int i = 0; i < 2; ++i) { rk[i] = *(const u32x4*)(kg[i] + (long)(jt + 1) * 64 * AW); rv[i] = *(const u32x4*)(vg[i] + (jt + 1) * 64); }
        }
        if (jt * 64 <= q0w + 31) {
            f32x16 sacc[2];
#pragma unroll
            for (int kb = 0; kb < 2; ++kb) {
#pragma unroll
                for (int r = 0; r < 16; ++r) sacc[kb][r] = 0.f;
#pragma unroll
                for (int kk = 0; kk < 4; ++kk) {
                    const bf16x8 kf = *(const bf16x8*)(cur + krow + kb * 4096 + coff[kk]);
                    sacc[kb] = MFMA32(kf, qf[kk], sacc[kb]);
                }
            }
            if (jt * 64 + 63 > q0w) {
                const int qpos = q0w + l31;
#pragma unroll
                for (int kb = 0; kb < 2; ++kb)
#pragma unroll
                    for (int r = 0; r < 16; ++r) { const int key = jt * 64 + kb * 32 + crow(r, hi); if (key > qpos) sacc[kb][r] = -1e30f; }
            }
            float mx = sacc[0][0];
#pragma unroll
            for (int kb = 0; kb < 2; ++kb)
#pragma unroll
                for (int r = 0; r < 16; ++r) mx = fmaxf(mx, sacc[kb][r]);
            mx = fmaxf(mx, __shfl_xor(mx, 32));
            const float mnew = fmaxf(m, mx);
            const float alpha = __builtin_amdgcn_exp2f(m - mnew);
            m = mnew;
            float ps = 0.f;
#pragma unroll
            for (int kb = 0; kb < 2; ++kb)
#pragma unroll
                for (int r = 0; r < 16; ++r) { const float pv = __builtin_amdgcn_exp2f(sacc[kb][r] - mnew); sacc[kb][r] = pv; ps += pv; }
            l = l * alpha + ps;
#pragma unroll
            for (int eb = 0; eb < 4; ++eb)
#pragma unroll
                for (int r = 0; r < 16; ++r) oacc[eb][r] *= alpha;
            bf16x8 pf[4];
#pragma unroll
            for (int ks = 0; ks < 4; ++ks) {
                const int kb = ks >> 1, s8 = (ks & 1) * 8;
                u32x4 w; w.x = pk2(sacc[kb][s8], sacc[kb][s8 + 1]); w.y = pk2(sacc[kb][s8 + 2], sacc[kb][s8 + 3]);
                w.z = pk2(sacc[kb][s8 + 4], sacc[kb][s8 + 5]); w.w = pk2(sacc[kb][s8 + 6], sacc[kb][s8 + 7]);
                pf[ks] = __builtin_bit_cast(bf16x8, w);
            }
#pragma unroll
            for (int eb = 0; eb < 4; ++eb)
#pragma unroll
                for (int ks = 0; ks < 4; ++ks) {
                    const bf16x8 vf = *(const bf16x8*)(cur + vrow + eb * 4096 + coff[ks]);
                    oacc[eb] = MFMA32(vf, pf[ks], oacc[eb]);
                }
        }
        if (more) {
#pragma unroll
            for (int i = 0; i < 2; ++i) { *(u32x4*)(nxt + ko[i]) = rk[i]; *(u32x4*)(nxt + vo[i]) = rv[i]; }
        }
        __syncthreads();
    }
    const float inv = 1.f / (l + __shfl_xor(l, 32));
    float* ex = (float*)lds + wq * 4096 + lane;
    if (c == 1) {
#pragma unroll
        for (int eb = 0; eb < 4; ++eb)
#pragma unroll
            for (int r = 0; r < 16; ++r) ex[(eb * 16 + r) * 64] = oacc[eb][r] * inv;
    }
    __syncthreads();
    if (c == 0) {
        float ss = 0.f;
#pragma unroll
        for (int eb = 0; eb < 4; ++eb)
#pragma unroll
            for (int r = 0; r < 16; ++r) { const float o = oacc[eb][r] * inv - lam * ex[(eb * 16 + r) * 64]; oacc[eb][r] = o; ss += o * o; }
        ss += __shfl_xor(ss, 32);
        const float rinv = rsqrtf(ss * (1.f / 128.f) + LN_EPS) * (1.f - LAM_INIT);
#pragma unroll
        for (int eb = 0; eb < 4; ++eb)
#pragma unroll
            for (int g = 0; g < 4; ++g) {
                const int e0 = eb * 32 + 8 * g + 4 * hi;
                const u32x2 gw = *(const u32x2*)(p.sga + tok * AW + h * 128 + e0);
                const f32x4 sg = *(const f32x4*)(p.subln_g + e0);
                u32x2 w;
                w.x = pk2(oacc[eb][4 * g] * rinv * sg.x * bflo(gw.x), oacc[eb][4 * g + 1] * rinv * sg.y * bfhi(gw.x));
                w.y = pk2(oacc[eb][4 * g + 2] * rinv * sg.z * bflo(gw.y), oacc[eb][4 * g + 3] * rinv * sg.w * bfhi(gw.y));
                *(u32x2*)(p.mixin + tok * DM + h * 128 + e0) = w;
            }
    }
    __syncthreads();
}

__device__ __forceinline__ void pool_unit(const P& p, const int rt, const int g, char* lds) {
    const int t = threadIdx.x, wid = t >> 6, lane = t & 63, wm = wid >> 2, wn = wid & 3, l31 = lane & 31, hi = lane >> 5;
    const int row0 = rt * 128, w = 2 << g;
    __syncthreads();
    {
        const int rr = t >> 4, ch = t & 15;
#pragma unroll
        for (int j = 0; j < 4; ++j) {
            const int row = row0 + rr * 4 + j, s = row % S;
            const int cnt = min(s + 1, w);
            float sum[8];
#pragma unroll
            for (int q = 0; q < 8; ++q) sum[q] = 0.f;
            u32x4 cur = {0u, 0u, 0u, 0u};
            for (int k = 0; k < cnt; ++k) {
                const u32x4 v = *(const u32x4*)(p.ub + (long)(row - k) * AW + g * 128 + ch * 8);
                if (k == 0) cur = v;
                sum[0] += bflo(v.x); sum[1] += bfhi(v.x); sum[2] += bflo(v.y); sum[3] += bfhi(v.y);
                sum[4] += bflo(v.z); sum[5] += bfhi(v.z); sum[6] += bflo(v.w); sum[7] += bfhi(v.w);
            }
            const float ic = 1.f / (float)cnt;
            u32x4 o;
            o.x = pk2(sum[0] * ic - bflo(cur.x), sum[1] * ic - bfhi(cur.x)); o.y = pk2(sum[2] * ic - bflo(cur.y), sum[3] * ic - bfhi(cur.y));
            o.z = pk2(sum[4] * ic - bflo(cur.z), sum[5] * ic - bfhi(cur.z)); o.w = pk2(sum[6] * ic - bflo(cur.w), sum[7] * ic - bfhi(cur.w));
            *(u32x4*)(lds + (ch >> 3) * 16384 + lds_off(rr * 4 + j, ch & 7)) = o;
        }
#pragma unroll
        for (int i = 0; i < 4; ++i) {
            const int id = t + NT * i, d = id >> 4, c16 = id & 15;
            const u32x4 v = *(const u32x4*)(p.wp_t + (long)g * 16384 + d * 128 + c16 * 8);
            *(u32x4*)(lds + 32768 + (c16 >> 3) * 16384 + lds_off(d, c16 & 7)) = v;
        }
    }
    __syncthreads();
    f32x16 acc[2];
#pragma unroll
    for (int i = 0; i < 2; ++i)
#pragma unroll
        for (int r = 0; r < 16; ++r) acc[i][r] = 0.f;
    const int sw = (l31 >> 1) & 7;
#pragma unroll
    for (int ks = 0; ks < 8; ++ks) {
        const int half = ks >> 2, co = (((ks & 3) * 2 + hi) ^ sw) << 4;
        const bf16x8 bf = *(const bf16x8*)(lds + 32768 + half * 16384 + (wn * 32 + l31) * 128 + co);
#pragma unroll
        for (int i = 0; i < 2; ++i) {
            const bf16x8 af = *(const bf16x8*)(lds + half * 16384 + (wm * 64 + i * 32 + l31) * 128 + co);
            acc[i] = MFMA32(bf, af, acc[i]);
        }
    }
#pragma unroll
    for (int i = 0; i < 2; ++i)
#pragma unroll
        for (int gg = 0; gg < 4; ++gg) {
            const long tok = row0 + wm * 64 + i * 32 + l31;
            const int col = g * 128 + wn * 32 + 8 * gg + 4 * hi;
            const f32x4 sc = *(const f32x4*)(p.pool_scale + col);
            const u32x2 gw = *(const u32x2*)(p.sgp + tok * AW + col);
            u32x2 o;
            o.x = pk2(acc[i][4 * gg] * sc.x * bflo(gw.x), acc[i][4 * gg + 1] * sc.y * bfhi(gw.x));
            o.y = pk2(acc[i][4 * gg + 2] * sc.z * bflo(gw.y), acc[i][4 * gg + 3] * sc.w * bfhi(gw.y));
            *(u32x2*)(p.mixin + tok * DM + 512 + col) = o;
        }
}

__device__ __forceinline__ void phase2(const P& p, char* lds) {
    for (int u = blockIdx.x; u < 512; u += gridDim.x) pool_unit(p, u >> 2, u & 3, lds);
    const float lam = compute_lam(p);
    for (int u = blockIdx.x; u < 256; u += gridDim.x) {
        const int bh = u & 15, qa = u >> 4;
        attn_item(p, bh >> 2, bh & 3, 31 - qa, lam, lds);
        attn_item(p, bh >> 2, bh & 3, qa, lam, lds);
    }
}

__device__ __forceinline__ void phase4(const P& p) {
    const int lane = threadIdx.x & 63, wid = threadIdx.x >> 6;
    for (int row = blockIdx.x * 8 + wid; row < M; row += gridDim.x * 8) {
        float* rp = p.out + (long)row * DM;
        f32x4 v[4];
        float sum = 0.f;
#pragma unroll
        for (int i = 0; i < 4; ++i) { v[i] = *(const f32x4*)(rp + i * 256 + lane * 4); sum += v[i].x + v[i].y + v[i].z + v[i].w; }
#pragma unroll
        for (int off = 32; off > 0; off >>= 1) sum += __shfl_xor(sum, off);
        const float mu = sum * (1.f / 1024.f);
        float sq = 0.f;
#pragma unroll
        for (int i = 0; i < 4; ++i) { v[i].x -= mu; v[i].y -= mu; v[i].z -= mu; v[i].w -= mu; sq += v[i].x * v[i].x + v[i].y * v[i].y + v[i].z * v[i].z + v[i].w * v[i].w; }
#pragma unroll
        for (int off = 32; off > 0; off >>= 1) sq += __shfl_xor(sq, off);
        const float rstd = rsqrtf(sq * (1.f / 1024.f) + LN_EPS);
#pragma unroll
        for (int i = 0; i < 4; ++i) {
            const int cc = i * 256 + lane * 4;
            const f32x4 g = *(const f32x4*)(p.ln_g + cc), bb = *(const f32x4*)(p.ln_b + cc);
            f32x4 hh; hh.x = v[i].x * rstd * g.x + bb.x; hh.y = v[i].y * rstd * g.y + bb.y; hh.z = v[i].z * rstd * g.z + bb.z; hh.w = v[i].w * rstd * g.w + bb.w;
            *(f32x4*)(rp + cc) = hh;
            u32x2 w; w.x = pk2(hh.x, hh.y); w.y = pk2(hh.z, hh.w);
            *(u32x2*)(p.hb + (long)row * DM + cc) = w;
        }
    }
}

#if MK_ONE
__global__ void __launch_bounds__(NT) mega(P p) {
    extern __shared__ __attribute__((aligned(16))) char lds[];
    cg::grid_group grid = cg::this_grid();
    phase0(p, lds); grid.sync();
    phase1(p, lds); grid.sync();
    phase2(p, lds); grid.sync();
    phase3(p, lds); grid.sync();
    phase4(p); grid.sync();
    phase5(p, lds);
}
#else
__global__ void __launch_bounds__(NT) k_p0(P p) { extern __shared__ __attribute__((aligned(16))) char lds[]; phase0(p, lds); }
__global__ void __launch_bounds__(NT) k_p1(P p) { extern __shared__ __attribute__((aligned(16))) char lds[]; phase1(p, lds); }
__global__ void __launch_bounds__(NT) k_p2(P p) { extern __shared__ __attribute__((aligned(16))) char lds[]; phase2(p, lds); }
__global__ void __launch_bounds__(NT) k_p3(P p) { extern __shared__ __attribute__((aligned(16))) char lds[]; phase3(p, lds); }
__global__ void __launch_bounds__(NT) k_p4(P p) { phase4(p); }
__global__ void __launch_bounds__(NT) k_p5(P p) { extern __shared__ __attribute__((aligned(16))) char lds[]; phase5(p, lds); }
#endif

extern "C" void kernel_launch(void* const* d_in, const int* in_sizes, int n_in, void* d_out, int out_size, void* d_ws, size_t ws_size, hipStream_t stream) {
    P p{};
    p.x = (const float*)d_in[0]; p.p = (const float*)d_in[1]; p.w_in = (const float*)d_in[2];
    p.lq1 = (const float*)d_in[3]; p.lk1 = (const float*)d_in[4]; p.lq2 = (const float*)d_in[5]; p.lk2 = (const float*)d_in[6];
    p.subln_g = (const float*)d_in[7]; p.w_pool = (const float*)d_in[8]; p.pool_scale = (const float*)d_in[9];
    p.w_out = (const float*)d_in[10]; p.ln_g = (const float*)d_in[11]; p.ln_b = (const float*)d_in[12];
    p.w_pe = (const float*)d_in[13]; p.w_pg = (const float*)d_in[14]; p.b_pg = (const float*)d_in[15];
    p.out = (float*)d_out;
    char* w = (char*)d_ws; size_t off = 0;
    auto take = [&](size_t bytes) { char* r = w + off; off += (bytes + 255) & ~(size_t)255; return (bf16_t*)r; };
    p.xb = take((size_t)M * DM * 2); p.pb = take((size_t)M * PLE * 2);
    p.wi_t = take((size_t)INW * DM * 2); p.wo_t = take((size_t)DM * DM * 2); p.wg_t = take((size_t)DM * DM * 2);
    p.we_t = take((size_t)DM * PLE * 2); p.wp_t = take((size_t)4 * 128 * 128 * 2);
    p.qb = take((size_t)M * AW * 2); p.kb = take((size_t)M * AW * 2); p.vT = take((size_t)M * AW * 2);
    p.sga = take((size_t)M * AW * 2); p.ub = take((size_t)M * AW * 2); p.sgp = take((size_t)M * AW * 2);
    p.pe = take((size_t)M * DM * 2); p.mixin = take((size_t)M * DM * 2);
    p.hb = p.xb;
    if (off > ws_size) { fprintf(stderr, "workspace too small: need %zu have %zu\n", off, ws_size); return; }
#if MK_ONE
    static int grid_blocks = 0;
    if (!grid_blocks) {
        int dev = 0, cus = 0, per_cu = 0;
        hipGetDevice(&dev);
        hipDeviceGetAttribute(&cus, hipDeviceAttributeMultiprocessorCount, dev);
        hipFuncSetAttribute((const void*)mega, hipFuncAttributeMaxDynamicSharedMemorySize, LDS_BYTES);
        hipOccupancyMaxActiveBlocksPerMultiprocessor(&per_cu, mega, NT, LDS_BYTES);
        if (per_cu > 1) per_cu = 1;
        grid_blocks = cus * per_cu;
    }
    void* args[] = {&p};
    hipError_t e = hipLaunchCooperativeKernel((void*)mega, dim3(grid_blocks), dim3(NT), args, LDS_BYTES, stream);
    if (e != hipSuccess) fprintf(stderr, "cooperative launch failed: %s (grid %d)\n", hipGetErrorString(e), grid_blocks);
#else
    hipFuncSetAttribute((const void*)k_p0, hipFuncAttributeMaxDynamicSharedMemorySize, LDS_BYTES);
    hipFuncSetAttribute((const void*)k_p1, hipFuncAttributeMaxDynamicSharedMemorySize, LDS_BYTES);
    hipFuncSetAttribute((const void*)k_p2, hipFuncAttributeMaxDynamicSharedMemorySize, LDS_BYTES);
    hipFuncSetAttribute((const void*)k_p3, hipFuncAttributeMaxDynamicSharedMemorySize, LDS_BYTES);
    hipFuncSetAttribute((const void*)k_p5, hipFuncAttributeMaxDynamicSharedMemorySize, LDS_BYTES);
    k_p0<<<256, NT, LDS_BYTES, stream>>>(p);
    k_p1<<<256, NT, LDS_BYTES, stream>>>(p);
    k_p2<<<256, NT, LDS_BYTES, stream>>>(p);
    k_p3<<<256, NT, LDS_BYTES, stream>>>(p);
    k_p4<<<256, NT, 0, stream>>>(p);
    k_p5<<<256, NT, LDS_BYTES, stream>>>(p);
#endif
}
```

```cpp
#include <hip/hip_runtime.h>
#include <hip/hip_cooperative_groups.h>
#include <cstdio>
#include <cstdint>
namespace cg = cooperative_groups;

#ifndef MK_ONE
#define MK_ONE 1
#endif

typedef unsigned short bf16_t;
typedef float f32x4 __attribute__((ext_vector_type(4)));
typedef float f32x16 __attribute__((ext_vector_type(16)));
typedef unsigned u32x4 __attribute__((ext_vector_type(4)));
typedef unsigned u32x2 __attribute__((ext_vector_type(2)));
typedef short bf16x8 __attribute__((ext_vector_type(8)));

constexpr int Bn = 4, S = 4096, DM = 1024, M = Bn * S, PLE = 256, INW = 3072, AW = 512;
constexpr float LN_EPS = 1e-5f;
constexpr float LAM_INIT = 0.2f;
constexpr float ALPHA = 1.189207115002721f;
constexpr float QSCALE = 0.125f * 1.4426950408889634f;
constexpr int NT = 512;
constexpr int LDS_BYTES = 131072;

struct P {
    const float *x, *p, *w_in, *lq1, *lk1, *lq2, *lk2, *subln_g, *w_pool, *pool_scale, *w_out, *ln_g, *ln_b, *w_pe, *w_pg, *b_pg;
    float* out;
    bf16_t *xb, *pb, *wi_t, *wo_t, *wg_t, *we_t, *wp_t;
    bf16_t *qb, *kb, *vT, *sga, *ub, *sgp, *pe, *mixin, *hb;
};

#define MFMA32(a, b, c) __builtin_amdgcn_mfma_f32_32x32x16_bf16((a), (b), (c), 0, 0, 0)
__device__ __forceinline__ int crow(int r, int hi) { return (r & 3) + 8 * (r >> 2) + 4 * hi; }
__device__ __forceinline__ float bf2f(bf16_t v) { return __uint_as_float(((unsigned)v) << 16); }
__device__ __forceinline__ float bflo(unsigned w) { return __uint_as_float(w << 16); }
__device__ __forceinline__ float bfhi(unsigned w) { return __uint_as_float(w & 0xffff0000u); }
typedef __bf16 bf16x2_t __attribute__((ext_vector_type(2)));
typedef float f32x2 __attribute__((ext_vector_type(2)));
__device__ __forceinline__ unsigned pk2(float lo, float hi) { const f32x2 f = {lo, hi}; return __builtin_bit_cast(unsigned, __builtin_convertvector(f, bf16x2_t)); }
__device__ __forceinline__ float silu(float v) { return v / (1.f + __expf(-v)); }
__device__ __forceinline__ float sigmoidf(float v) { return 1.f / (1.f + __expf(-v)); }
__device__ __forceinline__ int lds_off(int row, int chunk) { return row * 128 + ((chunk ^ ((row >> 1) & 7)) << 4); }

__device__ __forceinline__ float compute_lam(const P& p) {
    float a = 0.f, b = 0.f;
    for (int i = 0; i < 64; ++i) { a += p.lq1[i] * p.lk1[i]; b += p.lq2[i] * p.lk2[i]; }
    return expf(a) - expf(b) + LAM_INIT;
}

__device__ __forceinline__ void cvt_range(const float* __restrict__ src, bf16_t* __restrict__ dst, long n8) {
    for (long i = (long)blockIdx.x * NT + threadIdx.x; i < n8; i += (long)gridDim.x * NT) {
        const f32x4 a = *(const f32x4*)(src + i * 8), b = *(const f32x4*)(src + i * 8 + 4);
        u32x4 w; w.x = pk2(a.x, a.y); w.y = pk2(a.z, a.w); w.z = pk2(b.x, b.y); w.w = pk2(b.z, b.w);
        *(u32x4*)(dst + i * 8) = w;
    }
}
__device__ __forceinline__ void transpose_tile(const float* __restrict__ w, bf16_t* __restrict__ wt, int K, int N, int kt, int nt, float* tile  ) {
    const int t = threadIdx.x;
    __syncthreads();
#pragma unroll
    for (int i = 0; i < 8; ++i) { const int idx = t + NT * i, k = idx >> 6, n = idx & 63; tile[k * 65 + n] = w[(long)(kt * 64 + k) * N + nt * 64 + n]; }
    __syncthreads();
    {
        const int n = t >> 3, kc = t & 7;
        float v[8];
#pragma unroll
        for (int j = 0; j < 8; ++j) v[j] = tile[(kc * 8 + j) * 65 + n];
        u32x4 o; o.x = pk2(v[0], v[1]); o.y = pk2(v[2], v[3]); o.z = pk2(v[4], v[5]); o.w = pk2(v[6], v[7]);
        *(u32x4*)(wt + (long)(nt * 64 + n) * K + kt * 64 + kc * 8) = o;
    }
}
__device__ __forceinline__ void phase0(const P& p, char* lds) {
    float* tile = (float*)lds;
    for (int u = blockIdx.x; u < 1360; u += gridDim.x) {
        if (u < 768) transpose_tile(p.w_in, p.wi_t, DM, INW, u / 48, u % 48, tile);
        else if (u < 1024) { const int v = u - 768; transpose_tile(p.w_out, p.wo_t, DM, DM, v >> 4, v & 15, tile); }
        else if (u < 1280) { const int v = u - 1024; transpose_tile(p.w_pg, p.wg_t, DM, DM, v >> 4, v & 15, tile); }
        else if (u < 1344) { const int v = u - 1280; transpose_tile(p.w_pe, p.we_t, PLE, DM, v >> 4, v & 15, tile); }
        else { const int v = u - 1344, g = v >> 2; transpose_tile(p.w_pool + g * 16384, p.wp_t + g * 16384, 128, 128, (v >> 1) & 1, v & 1, tile); }
    }
    cvt_range(p.x, p.xb, (long)M * DM / 8);
    cvt_range(p.p, p.pb, (long)M * PLE / 8);
}

namespace pg8 {
#define PG8_LAS __attribute__((address_space(3)))
typedef unsigned short bf16_t;
typedef short bf16x8 __attribute__((ext_vector_type(8)));
typedef float f32x4 __attribute__((ext_vector_type(4)));
typedef unsigned u32x4 __attribute__((ext_vector_type(4)));
constexpr int BM = 256, BK = 64, HALF = 128, HTB = HALF * BK * 2  , STAGE_BYTES = 8 * HTB, NXCD = 8, WGM = 8;

__host__ __device__ __forceinline__ int lds_byte(int r, int c) { const int st = (r >> 4) * 2 + (c >> 5), rr = r & 15, cc = c & 31, ob = rr * 64 + cc * 2; return st * 1024 + (ob ^ (((ob >> 9) & 1) << 5)); }
__host__ __device__ __forceinline__ void stage_rc(int b, int& R, int& C) { const int st = b / 1024, sb = b % 1024, swz = sb ^ (((sb >> 9) & 1) << 5); R = (st >> 1) * 16 + swz / 64; C = (st & 1) * 32 + (swz % 64) / 2; }
__host__ __device__ __forceinline__ int perm32(int rho) { const int n = rho >> 4, i = rho & 15; return 8 * (i >> 2) + 4 * n + (i & 3); }

struct Unit { int pm, pn; };
struct Gemm { const bf16_t* A; const bf16_t* Bt; int M, N, K; };

struct StaticOrder {
    int nM, nN, nwg, G, c;
    __host__ __device__ void init(int M, int N, int G_, int c_) { nM = M / BM; nN = N / BM; nwg = nM * nN; G = G_; c = c_; }
    __host__ __device__ bool next(int i, Unit& u) const {
        const long L = (long)i * G + c; if (L >= nwg) return false;
        int wgid = (int)L; { const int q = nwg / NXCD, r = nwg % NXCD, xcd = wgid % NXCD, off = wgid / NXCD; wgid = (xcd < r ? xcd * (q + 1) : r * (q + 1) + (xcd - r) * q) + off; }
        const int nig = WGM * nN, gid = wgid / nig, fm = gid * WGM, gsz = (nM - fm) < WGM ? (nM - fm) : WGM;
        u.pm = fm + ((wgid % nig) % gsz); u.pn = (wgid % nig) / gsz; return true;
    }
    __device__ __forceinline__ void a_ready(const Unit&) const {}
    __device__ __forceinline__ void done(const Unit&) const {}
};


template <class Epi, class Sched, bool ALIGN_EPI = false, bool SP2 = false>
__device__ __forceinline__ void gemm_phase(PG8_LAS unsigned char* lds, const Gemm g, const Sched& S, const Epi& E) {
    const int tid = threadIdx.x, wid = __builtin_amdgcn_readfirstlane(tid >> 6), lane = tid & 63, wr = wid >> 2, wc = wid & 3, fr = lane & 15, fq = lane >> 4;
    const int K = g.K, nt = K / BK;
    unsigned voffA[2], voffB[2];
#pragma unroll
    for (int i = 0; i < 2; ++i) { int R, C; stage_rc(tid * 16 + i * 8192, R, C); const int Rb = Epi::PERM ? ((R & ~31) + perm32(R & 31)) : R;
        voffA[i] = (unsigned)(R * K + C) * 2u; voffB[i] = (unsigned)(Rb * K + C) * 2u; }
    const size_t kstep = (size_t)(BK * 2);
    const size_t hstep = (size_t)HALF * K * 2;
    const size_t tstep = 2 * hstep;
    const unsigned ldsw = (unsigned)wid * 1024u;
    const int aoff = lds_byte(wr * 64 + fr, fq * 8), boff = lds_byte(wc * 32 + fr, fq * 8);
#define PG8_SA(b, h) (((b) * 2 + (h)) * HTB)
#define PG8_SB(b, h) ((4 + (b) * 2 + (h)) * HTB)
#define PG8_STAGE(bufoff, gbase, voff) do { _Pragma("unroll") for (int _i = 0; _i < 2; ++_i) \
        __builtin_amdgcn_global_load_lds((const unsigned*)((const char*)(gbase) + (voff)[_i]), (PG8_LAS unsigned*)(lds + (bufoff) + ldsw + _i * 8192), 16, 0, 0); } while (0)
#define PG8_LDA(dst, b, h) do { _Pragma("unroll") for (int m = 0; m < 4; ++m) _Pragma("unroll") for (int k = 0; k < 2; ++k) dst[m][k] = *(const PG8_LAS bf16x8*)(lds + PG8_SA(b, h) + aoff + m * 2048 + k * 1024); } while (0)
#define PG8_LDB(dst, b, h) do { _Pragma("unroll") for (int n = 0; n < 2; ++n) _Pragma("unroll") for (int k = 0; k < 2; ++k) dst[n][k] = *(const PG8_LAS bf16x8*)(lds + PG8_SB(b, h) + boff + n * 2048 + k * 1024); } while (0)
#define PG8_MMA(ai, bj, At, Bt) do { __builtin_amdgcn_s_setprio(1); _Pragma("unroll") for (int m = 0; m < 4; ++m) _Pragma("unroll") for (int n = 0; n < 2; ++n) _Pragma("unroll") for (int k = 0; k < 2; ++k) \
        acc[ai][bj][m][n] = __builtin_amdgcn_mfma_f32_16x16x32_bf16(Bt[n][k], At[m][k], acc[ai][bj][m][n], 0, 0, 0); __builtin_amdgcn_s_setprio(0); } while (0)
#define PG8_WAIT_V(n) asm volatile("s_waitcnt vmcnt(" #n ")" ::: "memory")
#define PG8_WAIT_L(n) asm volatile("s_waitcnt lgkmcnt(" #n ")" ::: "memory")
#define PG8_BAR __builtin_amdgcn_s_barrier()
#define PG8_SCHED __builtin_amdgcn_sched_barrier(0)
    Unit cur, nxt; int ui = 0;
    if (!S.next(0, cur)) return;
    f32x4 acc[2][2][4][2];
#pragma unroll
    for (int a = 0; a < 2; ++a)
#pragma unroll
        for (int b = 0; b < 2; ++b)
#pragma unroll
            for (int m = 0; m < 4; ++m)
#pragma unroll
                for (int n = 0; n < 2; ++n) acc[a][b][m][n] = (f32x4){0.f, 0.f, 0.f, 0.f};
    bf16x8 At[4][2], B0[2][2], B1[2][2];
    const char* cA = (const char*)g.A + (size_t)cur.pm * tstep; const char* cB = (const char*)g.Bt + (size_t)cur.pn * tstep;
    S.a_ready(cur);
    if constexpr (SP2) {
        PG8_STAGE(PG8_SB(0, 0), cB, voffB); PG8_STAGE(PG8_SB(0, 1), cB + hstep, voffB); PG8_STAGE(PG8_SA(0, 0), cA, voffA); PG8_STAGE(PG8_SA(0, 1), cA + hstep, voffA);
        if (wr == 1) PG8_BAR;
        PG8_WAIT_V(2); PG8_BAR;
        PG8_STAGE(PG8_SB(1, 0), cB + kstep, voffB); PG8_STAGE(PG8_SA(1, 0), cA + kstep, voffA); PG8_STAGE(PG8_SB(1, 1), cB + hstep + kstep, voffB);
        PG8_WAIT_V(6); PG8_BAR;
    } else {
        PG8_STAGE(PG8_SB(0, 0), cB, voffB); PG8_STAGE(PG8_SA(0, 0), cA, voffA); PG8_STAGE(PG8_SB(0, 1), cB + hstep, voffB); PG8_STAGE(PG8_SA(0, 1), cA + hstep, voffA);
        if (wr == 1) PG8_BAR;
        PG8_WAIT_V(4); PG8_BAR;
        PG8_STAGE(PG8_SB(1, 0), cB + kstep, voffB); PG8_STAGE(PG8_SA(1, 0), cA + kstep, voffA); PG8_STAGE(PG8_SB(1, 1), cB + hstep + kstep, voffB);
        PG8_WAIT_V(6); PG8_BAR;
    }
    for (;;) {
        const bool has_next = S.next(ui + 1, nxt);
        const char* nA = has_next ? (const char*)g.A + (size_t)nxt.pm * tstep : cA; const char* nB = has_next ? (const char*)g.Bt + (size_t)nxt.pn * tstep : cB;
        for (int t = 0; t < nt; t += 2) {
            const bool last = (t == nt - 2);
            const char* a1 = cA + (size_t)(t + 1) * kstep;
            const char* a2 = last ? nA : cA + (size_t)(t + 2) * kstep; const char* b2 = last ? nB : cB + (size_t)(t + 2) * kstep;
            const char* a3 = a2 + kstep; const char* b3 = b2 + kstep;
            if (last && has_next) S.a_ready(nxt);
            if constexpr (SP2) {
            PG8_LDB(B0, 0, 0); PG8_LDB(B1, 0, 1); PG8_SCHED; PG8_LDA(At, 0, 0); PG8_STAGE(PG8_SA(1, 1), a1 + hstep, voffA);
            PG8_WAIT_V(8); PG8_WAIT_L(0); PG8_BAR; PG8_MMA(0, 0, At, B0); PG8_MMA(0, 1, At, B1); PG8_BAR; PG8_SCHED;
            PG8_LDA(At, 0, 1); PG8_STAGE(PG8_SB(0, 0), b2, voffB); PG8_STAGE(PG8_SB(0, 1), b2 + hstep, voffB); PG8_STAGE(PG8_SA(0, 0), a2, voffA);
            PG8_WAIT_V(8); PG8_WAIT_L(0); PG8_BAR; PG8_MMA(1, 0, At, B0); PG8_MMA(1, 1, At, B1); PG8_BAR; PG8_SCHED;
            PG8_LDB(B0, 1, 0); PG8_LDB(B1, 1, 1); PG8_SCHED; PG8_LDA(At, 1, 0); PG8_STAGE(PG8_SA(0, 1), a2 + hstep, voffA);
            PG8_WAIT_V(8); PG8_WAIT_L(0); PG8_BAR; PG8_MMA(0, 0, At, B0); PG8_MMA(0, 1, At, B1); PG8_BAR; PG8_SCHED;
            PG8_LDA(At, 1, 1); PG8_STAGE(PG8_SB(1, 0), b3, voffB); PG8_STAGE(PG8_SB(1, 1), b3 + hstep, voffB); PG8_STAGE(PG8_SA(1, 0), a3, voffA);
            PG8_WAIT_V(8); PG8_WAIT_L(0); PG8_BAR; PG8_MMA(1, 0, At, B0); PG8_MMA(1, 1, At, B1); PG8_BAR; PG8_SCHED;
            } else {
            PG8_LDB(B0, 0, 0); PG8_SCHED; PG8_LDA(At, 0, 0); PG8_STAGE(PG8_SA(1, 1), a1 + hstep, voffA);
            PG8_WAIT_L(8); PG8_BAR; PG8_WAIT_L(0); PG8_MMA(0, 0, At, B0); PG8_BAR; PG8_SCHED;
            PG8_LDB(B1, 0, 1); PG8_STAGE(PG8_SB(0, 0), b2, voffB);
            PG8_BAR; PG8_WAIT_L(0); PG8_MMA(0, 1, At, B1); PG8_BAR;
            PG8_LDA(At, 0, 1); PG8_STAGE(PG8_SA(0, 0), a2, voffA);
            PG8_BAR; PG8_WAIT_L(0); PG8_MMA(1, 0, At, B0); PG8_BAR; PG8_SCHED;
            PG8_STAGE(PG8_SB(0, 1), b2 + hstep, voffB);
            PG8_WAIT_V(6); PG8_BAR; PG8_MMA(1, 1, At, B1); PG8_BAR;
            PG8_LDB(B0, 1, 0); PG8_SCHED; PG8_LDA(At, 1, 0); PG8_STAGE(PG8_SA(0, 1), a2 + hstep, voffA);
            PG8_WAIT_L(8); PG8_BAR; PG8_WAIT_L(0); PG8_MMA(0, 0, At, B0); PG8_BAR; PG8_SCHED;
            PG8_LDB(B1, 1, 1); PG8_STAGE(PG8_SB(1, 0), b3, voffB);
            PG8_BAR; PG8_WAIT_L(0); PG8_MMA(0, 1, At, B1); PG8_BAR;
            PG8_LDA(At, 1, 1); PG8_STAGE(PG8_SA(1, 0), a3, voffA);
            PG8_BAR; PG8_WAIT_L(0); PG8_MMA(1, 0, At, B0); PG8_BAR; PG8_SCHED;
            PG8_STAGE(PG8_SB(1, 1), b3 + hstep, voffB);
            PG8_WAIT_V(6); PG8_BAR; PG8_MMA(1, 1, At, B1); PG8_BAR;
            }
        }
        if constexpr (ALIGN_EPI) { if (wr == 0) PG8_BAR; }
        if constexpr (!Epi::AFTER_DRAIN) { E(acc, cur, wr, wc, fr, fq); S.done(cur); }
        if (!has_next) break;
#pragma unroll
        for (int a = 0; a < 2; ++a)
#pragma unroll
            for (int b = 0; b < 2; ++b)
#pragma unroll
                for (int m = 0; m < 4; ++m)
#pragma unroll
                    for (int n = 0; n < 2; ++n) acc[a][b][m][n] = (f32x4){0.f, 0.f, 0.f, 0.f};
        cur = nxt; cA = nA; cB = nB; ++ui;
        if constexpr (ALIGN_EPI) { if (wr == 1) PG8_BAR; }
    }
    PG8_WAIT_V(0);
    if constexpr (!ALIGN_EPI) { if (wr == 0) PG8_BAR; }
    PG8_BAR;
    if constexpr (Epi::AFTER_DRAIN) { E.fused(acc, cur, wr, wc, fr, fq, lds, wid, lane); S.done(cur); }
#undef PG8_SA
#undef PG8_SB
#undef PG8_STAGE
#undef PG8_LDA
#undef PG8_LDB
#undef PG8_MMA
#undef PG8_WAIT_V
#undef PG8_WAIT_L
#undef PG8_BAR
#undef PG8_SCHED
}
}

typedef pg8::Unit Unit;
__device__ __forceinline__ u32x4 pack8(const f32x4 a, const f32x4 b) { u32x4 w; w.x = pk2(a.x, a.y); w.y = pk2(a.z, a.w); w.z = pk2(b.x, b.y); w.w = pk2(b.z, b.w); return w; }
__device__ __forceinline__ f32x4 silu4(const f32x4 v) { f32x4 r; r.x = silu(v.x); r.y = silu(v.y); r.z = silu(v.z); r.w = silu(v.w); return r; }
struct EpiIn {
    static constexpr bool PERM = true, AFTER_DRAIN = false;
    const P& p;
    __device__ __forceinline__ void operator()(const f32x4 (&acc)[2][2][4][2], const Unit& u, int wr, int wc, int fr, int fq) const {
        const int reg = u.pn >> 1;
        const int row0 = u.pm * 256 + wr * 64 + fr;
        const int cc0 = (u.pn & 1) * 256 + wc * 32 + 8 * fq;
        if (reg == 2) {
            const int piece = fr >> 2, np = ((piece & 1) << 1) | (piece >> 1), posl = (np << 2) | (fr & 3);
#pragma unroll
            for (int ai = 0; ai < 2; ++ai)
#pragma unroll
                for (int m = 0; m < 4; ++m) {
                    const int row = row0 + ai * 128 + m * 16, b = row / S, s = row % S;
                    bf16_t* base = p.vT + (long)b * 4 * 128 * S + (s & ~15) + posl;
#pragma unroll
                    for (int bj = 0; bj < 2; ++bj)
#pragma unroll
                        for (int n = 0; n < 2; ++n) {
                            const int col = cc0 + bj * 128 + 4 * n;
                            const unsigned w0 = pk2(acc[ai][bj][m][n].x, acc[ai][bj][m][n].y), w1 = pk2(acc[ai][bj][m][n].z, acc[ai][bj][m][n].w);
                            base[(long)(col + 0) * S] = (bf16_t)(w0 & 0xffffu); base[(long)(col + 1) * S] = (bf16_t)(w0 >> 16);
                            base[(long)(col + 2) * S] = (bf16_t)(w1 & 0xffffu); base[(long)(col + 3) * S] = (bf16_t)(w1 >> 16);
                        }
                }
        } else {
            bf16_t* d = reg == 0 ? p.qb : reg == 1 ? p.kb : reg == 3 ? p.sga : reg == 4 ? p.ub : p.sgp;
#pragma unroll
            for (int ai = 0; ai < 2; ++ai)
#pragma unroll
                for (int m = 0; m < 4; ++m) {
                    bf16_t* rowp = d + (long)(row0 + ai * 128 + m * 16) * AW + cc0;
#pragma unroll
                    for (int bj = 0; bj < 2; ++bj) {
                        f32x4 v0 = acc[ai][bj][m][0], v1 = acc[ai][bj][m][1];
                        if (reg == 0) { v0 = v0 * QSCALE; v1 = v1 * QSCALE; }
                        else if (reg == 3 || reg == 5) { v0 = silu4(v0); v1 = silu4(v1); }
                        *(u32x4*)(rowp + bj * 128) = pack8(v0, v1);
                    }
                }
        }
    }
};
struct EpiPe {
    static constexpr bool PERM = true, AFTER_DRAIN = false;
    const P& p;
    __device__ __forceinline__ void operator()(const f32x4 (&acc)[2][2][4][2], const Unit& u, int wr, int wc, int fr, int fq) const {
        const int row0 = u.pm * 256 + wr * 64 + fr, col0 = u.pn * 256 + wc * 32 + 8 * fq;
#pragma unroll
        for (int ai = 0; ai < 2; ++ai)
#pragma unroll
            for (int m = 0; m < 4; ++m)
#pragma unroll
                for (int bj = 0; bj < 2; ++bj) *(u32x4*)(p.pe + (long)(row0 + ai * 128 + m * 16) * DM + col0 + bj * 128) = pack8(acc[ai][bj][m][0], acc[ai][bj][m][1]);
    }
};
struct EpiOut {
    static constexpr bool PERM = true, AFTER_DRAIN = false;
    const P& p;
    __device__ __forceinline__ void operator()(const f32x4 (&acc)[2][2][4][2], const Unit& u, int wr, int wc, int fr, int fq) const {
        const int row0 = u.pm * 256 + wr * 64 + fr, col0 = u.pn * 256 + wc * 32 + 8 * fq;
#pragma unroll
        for (int ai = 0; ai < 2; ++ai)
#pragma unroll
            for (int m = 0; m < 4; ++m)
#pragma unroll
                for (int bj = 0; bj < 2; ++bj) {
                    const long o = (long)(row0 + ai * 128 + m * 16) * DM + col0 + bj * 128;
                    const f32x4 x0 = *(const f32x4*)(p.x + o), x1 = *(const f32x4*)(p.x + o + 4);
                    *(f32x4*)(p.out + o) = x0 * ALPHA + acc[ai][bj][m][0];
                    *(f32x4*)(p.out + o + 4) = x1 * ALPHA + acc[ai][bj][m][1];
                }
    }
};
struct EpiGate {
    static constexpr bool PERM = true, AFTER_DRAIN = false;
    const P& p;
    __device__ __forceinline__ void operator()(const f32x4 (&acc)[2][2][4][2], const Unit& u, int wr, int wc, int fr, int fq) const {
        const int row0 = u.pm * 256 + wr * 64 + fr, col0 = u.pn * 256 + wc * 32 + 8 * fq;
#pragma unroll
        for (int bj = 0; bj < 2; ++bj) {
            const f32x4 b0 = *(const f32x4*)(p.b_pg + col0 + bj * 128), b1 = *(const f32x4*)(p.b_pg + col0 + bj * 128 + 4);
#pragma unroll
            for (int ai = 0; ai < 2; ++ai)
#pragma unroll
                for (int m = 0; m < 4; ++m) {
                    const long o = (long)(row0 + ai * 128 + m * 16) * DM + col0 + bj * 128;
                    const f32x4 h0 = *(const f32x4*)(p.out + o), h1 = *(const f32x4*)(p.out + o + 4);
                    const u32x4 pw = *(const u32x4*)(p.pe + o);
                    const f32x4 a0 = acc[ai][bj][m][0] + b0, a1 = acc[ai][bj][m][1] + b1;
                    f32x4 r0, r1;
                    r0.x = h0.x + bflo(pw.x) * sigmoidf(a0.x); r0.y = h0.y + bfhi(pw.x) * sigmoidf(a0.y); r0.z = h0.z + bflo(pw.y) * sigmoidf(a0.z); r0.w = h0.w + bfhi(pw.y) * sigmoidf(a0.w);
                    r1.x = h1.x + bflo(pw.z) * sigmoidf(a1.x); r1.y = h1.y + bfhi(pw.z) * sigmoidf(a1.y); r1.z = h1.z + bflo(pw.w) * sigmoidf(a1.z); r1.w = h1.w + bfhi(pw.w) * sigmoidf(a1.w);
                    *(f32x4*)(p.out + o) = r0; *(f32x4*)(p.out + o + 4) = r1;
                }
        }
    }
};
template <class Epi, bool ALIGN> __device__ __forceinline__ void run_gemm(const P& p, const bf16_t* A, const bf16_t* Bt, int N, int K, char* lds) {
    pg8::Gemm g{A, Bt, M, N, K};
    pg8::StaticOrder So; So.init(M, N, (int)gridDim.x, (int)blockIdx.x);
    Epi E{p};
    pg8::gemm_phase<Epi, pg8::StaticOrder, ALIGN, true>((PG8_LAS unsigned char*)lds, g, So, E);
}
__device__ __forceinline__ void phase1(const P& p, char* lds) {
    run_gemm<EpiIn, true>(p, p.xb, p.wi_t, INW, DM, lds);
    run_gemm<EpiPe, false>(p, p.pb, p.we_t, DM, PLE, lds);
}
__device__ __forceinline__ void phase3(const P& p, char* lds) { run_gemm<EpiOut, false>(p, p.mixin, p.wo_t, DM, DM, lds); }
__device__ __forceinline__ void phase5(const P& p, char* lds) { run_gemm<EpiGate, false>(p, p.hb, p.wg_t, DM, DM, lds); }

__device__ __forceinline__ void attn_item(const P& p, const int b, const int h, const int qt, const float lam, char* lds) {
    const int t = threadIdx.x, wid = t >> 6, lane = t & 63, c = wid >> 2, wq = wid & 3, l31 = lane & 31, hi = lane >> 5;
    const int q0w = qt * 128 + wq * 32;
    const long tok = (long)b * S + q0w + l31;
    bf16x8 qf[4];
#pragma unroll
    for (int kk = 0; kk < 4; ++kk) qf[kk] = *(const bf16x8*)(p.qb + tok * AW + h * 128 + c * 64 + (kk * 2 + hi) * 8);
    f32x16 oacc[4];
#pragma unroll
    for (int eb = 0; eb < 4; ++eb)
#pragma unroll
        for (int r = 0; r < 16; ++r) oacc[eb][r] = 0.f;
    float m = -1e30f, l = 0.f;
    const int ntile = 2 * qt + 2;
    const bf16_t* kg[2]; const bf16_t* vg[2]; int ko[2], vo[2];
#pragma unroll
    for (int i = 0; i < 2; ++i) {
        const int id = t + NT * i, key = id >> 4, c16 = id & 15;
        kg[i] = p.kb + ((long)b * S + key) * AW + h * 128 + c16 * 8;
        ko[i] = (c16 >> 3) * 8192 + lds_off(key, c16 & 7);
        const int e = id >> 3, ch = id & 7;
        vg[i] = p.vT + ((long)(b * 4 + h) * 128 + e) * S + ch * 8;
        vo[i] = 16384 + lds_off(e, ch);
    }
    const int sw = (l31 >> 1) & 7;
    int coff[4];
#pragma unroll
    for (int kk = 0; kk < 4; ++kk) coff[kk] = ((kk * 2 + hi) ^ sw) << 4;
    const int krow = c * 8192 + l31 * 128, vrow = 16384 + l31 * 128;
    u32x4 rk[2], rv[2];
#pragma unroll
    for (int i = 0; i < 2; ++i) { rk[i] = *(const u32x4*)(kg[i]); rv[i] = *(const u32x4*)(vg[i]); }
    __syncthreads();
#pragma unroll
    for (int i = 0; i < 2; ++i) { *(u32x4*)(lds + ko[i]) = rk[i]; *(u32x4*)(lds + vo[i]) = rv[i]; }
    __syncthreads();
    for (int jt = 0; jt < ntile; ++jt) {
        const char* cur = lds + (jt & 1) * 32768;
        char* nxt = lds + ((jt + 1) & 1) * 32768;
        const bool more = jt + 1 < ntile;
        if (more) {
#pragma unroll
            for (int i = 0; i < 2; ++i) { rk[i] = *(const u32x4*)(kg[i] + (long)(jt + 1) * 64 * AW); rv[i] = *(const u32x4*)(vg[i] + (jt + 1) * 64); }
        }
        if (jt * 64 <= q0w + 31) {
            f32x16 sacc[2];
#pragma unroll
            for (int kb = 0; kb < 2; ++kb) {
#pragma unroll
                for (int r = 0; r < 16; ++r) sacc[kb][r] = 0.f;
#pragma unroll
                for (int kk = 0; kk < 4; ++kk) {
                    const bf16x8 kf = *(const bf16x8*)(cur + krow + kb * 4096 + coff[kk]);
                    sacc[kb] = MFMA32(kf, qf[kk], sacc[kb]);
                }
            }
            if (jt * 64 + 63 > q0w) {
                const int qpos = q0w + l31;
#pragma unroll
                for (int kb = 0; kb < 2; ++kb)
#pragma unroll
                    for (int r = 0; r < 16; ++r) { const int key = jt * 64 + kb * 32 + crow(r, hi); if (key > qpos) sacc[kb][r] = -1e30f; }
            }
            float mx = sacc[0][0];
#pragma unroll
            for (int kb = 0; kb < 2; ++kb)
#pragma unroll
                for (int r = 0; r < 16; ++r) mx = fmaxf(mx, sacc[kb][r]);
            mx = fmaxf(mx, __shfl_xor(mx, 32));
            const float mnew = fmaxf(m, mx);
            const float alpha = __builtin_amdgcn_exp2f(m - mnew);
            m = mnew;
            float ps = 0.f;
#pragma unroll
            for (int kb = 0; kb < 2; ++kb)
#pragma unroll
                for (int r = 0; r < 16; ++r) { const float pv = __builtin_amdgcn_exp2f(sacc[kb][r] - mnew); sacc[kb][r] = pv; ps += pv; }
            l = l * alpha + ps;
#pragma unroll
            for (int eb = 0; eb < 4; ++eb)
#pragma unroll
                for (int r = 0; r < 16; ++r) oacc[eb][r] *= alpha;
            bf16x8 pf[4];
#pragma unroll
            for (int ks = 0; ks < 4; ++ks) {
                const int kb = ks >> 1, s8 = (ks & 1) * 8;
                u32x4 w; w.x = pk2(sacc[kb][s8], sacc[kb][s8 + 1]); w.y = pk2(sacc[kb][s8 + 2], sacc[kb][s8 + 3]);
                w.z = pk2(sacc[kb][s8 + 4], sacc[kb][s8 + 5]); w.w = pk2(sacc[kb][s8 + 6], sacc[kb][s8 + 7]);
                pf[ks] = __builtin_bit_cast(bf16x8, w);
            }
#pragma unroll
            for (int eb = 0; eb < 4; ++eb)
#pragma unroll
                for (int ks = 0; ks < 4; ++ks) {
                    const bf16x8 vf = *(const bf16x8*)(cur + vrow + eb * 4096 + coff[ks]);
                    oacc[eb] = MFMA32(vf, pf[ks], oacc[eb]);
                }
        }
        if (more) {
#pragma unroll
            for (int i = 0; i < 2; ++i) { *(u32x4*)(nxt + ko[i]) = rk[i]; *(u32x4*)(nxt + vo[i]) = rv[i]; }
        }
        __syncthreads();
    }
    const float inv = 1.f / (l + __shfl_xor(l, 32));
    float* ex = (float*)lds + wq * 4096 + lane;
    if (c == 1) {
#pragma unroll
        for (int eb = 0; eb < 4; ++eb)
#pragma unroll
            for (int r = 0; r < 16; ++r) ex[(eb * 16 + r) * 64] = oacc[eb][r] * inv;
    }
    __syncthreads();
    if (c == 0) {
        float ss = 0.f;
#pragma unroll
        for (int eb = 0; eb < 4; ++eb)
#pragma unroll
            for (int r = 0; r < 16; ++r) { const float o = oacc[eb][r] * inv - lam * ex[(eb * 16 + r) * 64]; oacc[eb][r] = o; ss += o * o; }
        ss += __shfl_xor(ss, 32);
        const float rinv = rsqrtf(ss * (1.f / 128.f) + LN_EPS) * (1.f - LAM_INIT);
#pragma unroll
        for (int eb = 0; eb < 4; ++eb)
#pragma unroll
            for (int g = 0; g < 4; ++g) {
                const int e0 = eb * 32 + 8 * g + 4 * hi;
                const u32x2 gw = *(const u32x2*)(p.sga + tok * AW + h * 128 + e0);
                const f32x4 sg = *(const f32x4*)(p.subln_g + e0);
                u32x2 w;
                w.x = pk2(oacc[eb][4 * g] * rinv * sg.x * bflo(gw.x), oacc[eb][4 * g + 1] * rinv * sg.y * bfhi(gw.x));
                w.y = pk2(oacc[eb][4 * g + 2] * rinv * sg.z * bflo(gw.y), oacc[eb][4 * g + 3] * rinv * sg.w * bfhi(gw.y));
                *(u32x2*)(p.mixin + tok * DM + h * 128 + e0) = w;
            }
    }
    __syncthreads();
}

__device__ __forceinline__ void pool_unit(const P& p, const int rt, const int g, char* lds) {
    const int t = threadIdx.x, wid = t >> 6, lane = t & 63, wm = wid >> 2, wn = wid & 3, l31 = lane & 31, hi = lane >> 5;
    const int row0 = rt * 128, w = 2 << g;
    __syncthreads();
    {
        const int rr = t >> 4, ch = t & 15;
#pragma unroll
        for (int j = 0; j < 4; ++j) {
            const int row = row0 + rr * 4 + j, s = row % S;
            const int cnt = min(s + 1, w);
            float sum[8];
#pragma unroll
            for (int q = 0; q < 8; ++q) sum[q] = 0.f;
            u32x4 cur = {0u, 0u, 0u, 0u};
            for (int k = 0; k < cnt; ++k) {
                const u32x4 v = *(const u32x4*)(p.ub + (long)(row - k) * AW + g * 128 + ch * 8);
                if (k == 0) cur = v;
                sum[0] += bflo(v.x); sum[1] += bfhi(v.x); sum[2] += bflo(v.y); sum[3] += bfhi(v.y);
                sum[4] += bflo(v.z); sum[5] += bfhi(v.z); sum[6] += bflo(v.w); sum[7] += bfhi(v.w);
            }
            const float ic = 1.f / (float)cnt;
            u32x4 o;
            o.x = pk2(sum[0] * ic - bflo(cur.x), sum[1] * ic - bfhi(cur.x)); o.y = pk2(sum[2] * ic - bflo(cur.y), sum[3] * ic - bfhi(cur.y));
            o.z = pk2(sum[4] * ic - bflo(cur.z), sum[5] * ic - bfhi(cur.z)); o.w = pk2(sum[6] * ic - bflo(cur.w), sum[7] * ic - bfhi(cur.w));
            *(u32x4*)(lds + (ch >> 3) * 16384 + lds_off(rr * 4 + j, ch & 7)) = o;
        }
#pragma unroll
        for (int i = 0; i < 4; ++i) {
            const int id = t + NT * i, d = id >> 4, c16 = id & 15;
            const u32x4 v = *(const u32x4*)(p.wp_t + (long)g * 16384 + d * 128 + c16 * 8);
            *(u32x4*)(lds + 32768 + (c16 >> 3) * 16384 + lds_off(d, c16 & 7)) = v;
        }
    }
    __syncthreads();
    f32x16 acc[2];
#pragma unroll
    for (int i = 0; i < 2; ++i)
#pragma unroll
        for (int r = 0; r < 16; ++r) acc[i][r] = 0.f;
    const int sw = (l31 >> 1) & 7;
#pragma unroll
    for (int ks = 0; ks < 8; ++ks) {
        const int half = ks >> 2, co = (((ks & 3) * 2 + hi) ^ sw) << 4;
        const bf16x8 bf = *(const bf16x8*)(lds + 32768 + half * 16384 + (wn * 32 + l31) * 128 + co);
#pragma unroll
        for (int i = 0; i < 2; ++i) {
            const bf16x8 af = *(const bf16x8*)(lds + half * 16384 + (wm * 64 + i * 32 + l31) * 128 + co);
            acc[i] = MFMA32(bf, af, acc[i]);
        }
    }
#pragma unroll
    for (int i = 0; i < 2; ++i)
#pragma unroll
        for (int gg = 0; gg < 4; ++gg) {
            const long tok = row0 + wm * 64 + i * 32 + l31;
            const int col = g * 128 + wn * 32 + 8 * gg + 4 * hi;
            const f32x4 sc = *(const f32x4*)(p.pool_scale + col);
            const u32x2 gw = *(const u32x2*)(p.sgp + tok * AW + col);
            u32x2 o;
            o.x = pk2(acc[i][4 * gg] * sc.x * bflo(gw.x), acc[i][4 * gg + 1] * sc.y * bfhi(gw.x));
            o.y = pk2(acc[i][4 * gg + 2] * sc.z * bflo(gw.y), acc[i][4 * gg + 3] * sc.w * bfhi(gw.y));
            *(u32x2*)(p.mixin + tok * DM + 512 + col) = o;
        }
}

__device__ __forceinline__ void phase2(const P& p, char* lds) {
    for (int u = blockIdx.x; u < 512; u += gridDim.x) pool_unit(p, u >> 2, u & 3, lds);
    const float lam = compute_lam(p);
    for (int u = blockIdx.x; u < 256; u += gridDim.x) {
        const int bh = u & 15, qa = u >> 4;
        attn_item(p, bh >> 2, bh & 3, 31 - qa, lam, lds);
        attn_item(p, bh >> 2, bh & 3, qa, lam, lds);
    }
}

__device__ __forceinline__ void phase4(const P& p) {
    const int lane = threadIdx.x & 63, wid = threadIdx.x >> 6;
    for (int row = blockIdx.x * 8 + wid; row < M; row += gridDim.x * 8) {
        float* rp = p.out + (long)row * DM;
        f32x4 v[4];
        float sum = 0.f;
#pragma unroll
        for (int i = 0; i < 4; ++i) { v[i] = *(const f32x4*)(rp + i * 256 + lane * 4); sum += v[i].x + v[i].y + v[i].z + v[i].w; }
#pragma unroll
        for (int off = 32; off > 0; off >>= 1) sum += __shfl_xor(sum, off);
        const float mu = sum * (1.f / 1024.f);
        float sq = 0.f;
#pragma unroll
        for (int i = 0; i < 4; ++i) { v[i].x -= mu; v[i].y -= mu; v[i].z -= mu; v[i].w -= mu; sq += v[i].x * v[i].x + v[i].y * v[i].y + v[i].z * v[i].z + v[i].w * v[i].w; }
#pragma unroll
        for (int off = 32; off > 0; off >>= 1) sq += __shfl_xor(sq, off);
        const float rstd = rsqrtf(sq * (1.f / 1024.f) + LN_EPS);
#pragma unroll
        for (int i = 0; i < 4; ++i) {
            const int cc = i * 256 + lane * 4;
            const f32x4 g = *(const f32x4*)(p.ln_g + cc), bb = *(const f32x4*)(p.ln_b + cc);
            f32x4 hh; hh.x = v[i].x * rstd * g.x + bb.x; hh.y = v[i].y * rstd * g.y + bb.y; hh.z = v[i].z * rstd * g.z + bb.z; hh.w = v[i].w * rstd * g.w + bb.w;
            *(f32x4*)(rp + cc) = hh;
            u32x2 w; w.x = pk2(hh.x, hh.y); w.y = pk2(hh.z, hh.w);
            *(u32x2*)(p.hb + (long)row * DM + cc) = w;
        }
    }
}

#if MK_ONE
__global__ void __launch_bounds__(NT) mega(P p) {
    extern __shared__ __attribute__((aligned(16))) char lds[];
    cg::grid_group grid = cg::this_grid();
    phase0(p, lds); grid.sync();
    phase1(p, lds); grid.sync();
    phase2(p, lds); grid.sync();
    phase3(p, lds); grid.sync();
    phase4(p); grid.sync();
    phase5(p, lds);
}
#else
__global__ void __launch_bounds__(NT) k_p0(P p) { extern __shared__ __attribute__((aligned(16))) char lds[]; phase0(p, lds); }
__global__ void __launch_bounds__(NT) k_p1(P p) { extern __shared__ __attribute__((aligned(16))) char lds[]; phase1(p, lds); }
__global__ void __launch_bounds__(NT) k_p2(P p) { extern __shared__ __attribute__((aligned(16))) char lds[]; phase2(p, lds); }
__global__ void __launch_bounds__(NT) k_p3(P p) { extern __shared__ __attribute__((aligned(16))) char lds[]; phase3(p, lds); }
__global__ void __launch_bounds__(NT) k_p4(P p) { phase4(p); }
__global__ void __launch_bounds__(NT) k_p5(P p) { extern __shared__ __attribute__((aligned(16))) char lds[]; phase5(p, lds); }
#endif

extern "C" void kernel_launch(void* const* d_in, const int* in_sizes, int n_in, void* d_out, int out_size, void* d_ws, size_t ws_size, hipStream_t stream) {
    P p{};
    p.x = (const float*)d_in[0]; p.p = (const float*)d_in[1]; p.w_in = (const float*)d_in[2];
    p.lq1 = (const float*)d_in[3]; p.lk1 = (const float*)d_in[4]; p.lq2 = (const float*)d_in[5]; p.lk2 = (const float*)d_in[6];
    p.subln_g = (const float*)d_in[7]; p.w_pool = (const float*)d_in[8]; p.pool_scale = (const float*)d_in[9];
    p.w_out = (const float*)d_in[10]; p.ln_g = (const float*)d_in[11]; p.ln_b = (const float*)d_in[12];
    p.w_pe = (const float*)d_in[13]; p.w_pg = (const float*)d_in[14]; p.b_pg = (const float*)d_in[15];
    p.out = (float*)d_out;
    char* w = (char*)d_ws; size_t off = 0;
    auto take = [&](size_t bytes) { char* r = w + off; off += (bytes + 255) & ~(size_t)255; return (bf16_t*)r; };
    p.xb = take((size_t)M * DM * 2); p.pb = take((size_t)M * PLE * 2);
    p.wi_t = take((size_t)INW * DM * 2); p.wo_t = take((size_t)DM * DM * 2); p.wg_t = take((size_t)DM * DM * 2);
    p.we_t = take((size_t)DM * PLE * 2); p.wp_t = take((size_t)4 * 128 * 128 * 2);
    p.qb = take((size_t)M * AW * 2); p.kb = take((size_t)M * AW * 2); p.vT = take((size_t)M * AW * 2);
    p.sga = take((size_t)M * AW * 2); p.ub = take((size_t)M * AW * 2); p.sgp = take((size_t)M * AW * 2);
    p.pe = take((size_t)M * DM * 2); p.mixin = take((size_t)M * DM * 2);
    p.hb = p.xb;
    if (off > ws_size) { fprintf(stderr, "workspace too small: need %zu have %zu\n", off, ws_size); return; }
#if MK_ONE
    static int grid_blocks = 0;
    if (!grid_blocks) {
        int dev = 0, cus = 0, per_cu = 0;
        hipGetDevice(&dev);
        hipDeviceGetAttribute(&cus, hipDeviceAttributeMultiprocessorCount, dev);
        hipFuncSetAttribute((const void*)mega, hipFuncAttributeMaxDynamicSharedMemorySize, LDS_BYTES);
        hipOccupancyMaxActiveBlocksPerMultiprocessor(&per_cu, mega, NT, LDS_BYTES);
        if (per_cu > 1) per_cu = 1;
        grid_blocks = cus * per_cu;
    }
    void* args[] = {&p};
    hipError_t e = hipLaunchCooperativeKernel((void*)mega, dim3(grid_blocks), dim3(NT), args, LDS_BYTES, stream);
    if (e != hipSuccess) fprintf(stderr, "cooperative launch failed: %s (grid %d)\n", hipGetErrorString(e), grid_blocks);
#else
    hipFuncSetAttribute((const void*)k_p0, hipFuncAttributeMaxDynamicSharedMemorySize, LDS_BYTES);
    hipFuncSetAttribute((const void*)k_p1, hipFuncAttributeMaxDynamicSharedMemorySize, LDS_BYTES);
    hipFuncSetAttribute((const void*)k_p2, hipFuncAttributeMaxDynamicSharedMemorySize, LDS_BYTES);
    hipFuncSetAttribute((const void*)k_p3, hipFuncAttributeMaxDynamicSharedMemorySize, LDS_BYTES);
    hipFuncSetAttribute((const void*)k_p5, hipFuncAttributeMaxDynamicSharedMemorySize, LDS_BYTES);
    k_p0<<<256, NT, LDS_BYTES, stream>>>(p);
    k_p1<<<256, NT, LDS_BYTES, stream>>>(p);
    k_p2<<<256, NT, LDS_BYTES, stream>>>(p);
    k_p3<<<256, NT, LDS_BYTES, stream>>>(p);
    k_p4<<<256, NT, 0, stream>>>(p);
    k_p5<<<256, NT, LDS_BYTES, stream>>>(p);
#endif
}
```
